# Optimizing an MI355X kernel written in HIP

```python
import jax, jax.numpy as jnp
from jax import lax
import numpy as np

D_MODEL = 1024
BATCH = 16
SEQ = 4096
DEPTH = 4

GRID_W = 64
NA_HEADS = 8
NA_HEAD_DIM = 64
NA_WIDTH = NA_HEADS * NA_HEAD_DIM
NA_WIN_ROWS = 8
NA_WIN_COLS = 16
MLA_HEADS = 8
MLA_NOPE = 64
MLA_ROPE = 32
MLA_QK_DIM = MLA_NOPE + MLA_ROPE
MLA_V = 64
MLA_Q_LORA = 256
MLA_KV_LORA = 128
MLA_WIDTH = MLA_HEADS * MLA_V
ROPE_BASE = 10000.0
Q_BLOCK = 128
EPS = 1e-6
IN_SPLIT_SIZES = (NA_WIDTH, NA_WIDTH, NA_WIDTH, NA_WIDTH,
                  MLA_Q_LORA, MLA_KV_LORA, MLA_ROPE, MLA_WIDTH,
                  D_MODEL, D_MODEL)
D_IN = sum(IN_SPLIT_SIZES)

kernel_name = "hybrid_natten_mla_gated_encoder"


def rmsnorm(x, g):
    xf = x.astype(jnp.float32)
    y = xf * lax.rsqrt(jnp.mean(xf * xf, axis=-1, keepdims=True) + EPS)
    return (y * g.astype(jnp.float32)).astype(x.dtype)


def split_columns(p):
    parts, off = [], 0
    for size in IN_SPLIT_SIZES:
        parts.append(p[..., off:off + size])
        off += size
    return parts


def axial_rope_tables(seq_len):
    t = jnp.arange(seq_len)
    row = (t // GRID_W).astype(jnp.float32)
    col = (t % GRID_W).astype(jnp.float32)
    half = MLA_ROPE // 2
    n_freq = half // 2
    inv = jnp.power(jnp.float32(ROPE_BASE), -jnp.arange(n_freq, dtype=jnp.float32) / n_freq)
    ang = jnp.concatenate([row[:, None] * inv, col[:, None] * inv], axis=-1)
    return jnp.cos(ang), jnp.sin(ang)


def apply_rope(x, cos, sin):
    half = MLA_ROPE // 2
    x1, x2 = x[..., :half], x[..., half:]
    c, s = cos[None, :, None, :], sin[None, :, None, :]
    out = jnp.concatenate([x1 * c - x2 * s, x1 * s + x2 * c], axis=-1)
    return out.astype(x.dtype)


def neighborhood_attention(q, k, v, rel_bias):
    B, S, H, d = q.shape
    rows = S // GRID_W
    kr = min(NA_WIN_ROWS, rows)
    kw = NA_WIN_COLS
    kg = k.reshape(B, rows, GRID_W, H, d)
    vg = v.reshape(B, rows, GRID_W, H, d)
    qg = q.reshape(B, rows, GRID_W, H, d).transpose(1, 0, 2, 3, 4)
    cols = jnp.arange(GRID_W)
    col_start = jnp.clip(cols - kw // 2, 0, GRID_W - kw)
    col_idx = col_start[:, None] + jnp.arange(kw)[None, :]
    dcol = col_idx - cols[:, None] + (kw - 1)
    row_ids = jnp.arange(rows)
    row_start = jnp.clip(row_ids - kr // 2, 0, rows - kr)
    scale = d ** -0.5

    def one_row(args):
        q_row, r, rs = args
        k_band = lax.dynamic_slice_in_dim(kg, rs, kr, axis=1)
        v_band = lax.dynamic_slice_in_dim(vg, rs, kr, axis=1)
        k_win = k_band[:, :, col_idx]
        v_win = v_band[:, :, col_idx]
        s = jnp.einsum('bqhd,bnqjhd->bhqnj', q_row, k_win).astype(jnp.float32) * scale
        drow = rs + jnp.arange(kr) - r + (NA_WIN_ROWS - 1)
        bias = rel_bias[:, drow[None, :, None], dcol[:, None, :]]
        s = s + bias[None].astype(jnp.float32)
        p = jax.nn.softmax(s.reshape(B, H, GRID_W, kr * kw), axis=-1)
        p = p.reshape(B, H, GRID_W, kr, kw).astype(v.dtype)
        return jnp.einsum('bhqnj,bnqjhd->bqhd', p, v_win)

    o = lax.map(one_row, (qg, row_ids, row_start))
    return o.transpose(1, 0, 2, 3, 4).reshape(B, S, H * d)


def dense_block_attention(q, k, v):
    B, S, H, dk = q.shape
    dv = v.shape[-1]
    nblk = S // Q_BLOCK
    scale = dk ** -0.5
    qb = q.reshape(B, nblk, Q_BLOCK, H, dk).transpose(1, 0, 2, 3, 4)

    def one_block(q_blk):
        s = jnp.einsum('bqhd,bkhd->bhqk', q_blk, k).astype(jnp.float32) * scale
        p = jax.nn.softmax(s, axis=-1).astype(v.dtype)
        return jnp.einsum('bhqk,bkhd->bqhd', p, v)

    o = lax.map(one_block, qb)
    return o.transpose(1, 0, 2, 3, 4).reshape(B, S, H * dv)


def hybrid_layer(x, ln_g, w_in, na_q_norm, na_k_norm, na_rel_bias,
                 mla_cq_norm, mla_ckv_norm, w_uq, w_ukv, mla_q_norm, mla_k_norm,
                 w_o_na, w_o_mla, w_out, rope_cos, rope_sin):
    B, S, _ = x.shape
    h = rmsnorm(x, ln_g)
    proj = h @ w_in
    (na_q, na_k, na_v, na_gate, c_q, c_kv, k_pe, mla_gate,
     g_na, g_mla) = split_columns(proj)

    qa = rmsnorm(na_q.reshape(B, S, NA_HEADS, NA_HEAD_DIM), na_q_norm)
    ka = rmsnorm(na_k.reshape(B, S, NA_HEADS, NA_HEAD_DIM), na_k_norm)
    va = na_v.reshape(B, S, NA_HEADS, NA_HEAD_DIM)
    o_na = neighborhood_attention(qa, ka, va, na_rel_bias) * jax.nn.silu(na_gate)
    u_na = o_na @ w_o_na

    qb = (rmsnorm(c_q, mla_cq_norm) @ w_uq).reshape(B, S, MLA_HEADS, MLA_QK_DIM)
    kv = (rmsnorm(c_kv, mla_ckv_norm) @ w_ukv).reshape(B, S, MLA_HEADS, MLA_NOPE + MLA_V)
    k_nope, vb = kv[..., :MLA_NOPE], kv[..., MLA_NOPE:]
    k_rot = jnp.broadcast_to(k_pe[:, :, None, :], (B, S, MLA_HEADS, MLA_ROPE))
    kb = jnp.concatenate([k_nope, k_rot], axis=-1)
    qb = rmsnorm(qb, mla_q_norm)
    kb = rmsnorm(kb, mla_k_norm)
    qb = jnp.concatenate([qb[..., :MLA_NOPE], apply_rope(qb[..., MLA_NOPE:], rope_cos, rope_sin)], axis=-1)
    kb = jnp.concatenate([kb[..., :MLA_NOPE], apply_rope(kb[..., MLA_NOPE:], rope_cos, rope_sin)], axis=-1)
    o_mla = dense_block_attention(qb, kb, vb) * jax.nn.silu(mla_gate)
    u_mla = o_mla @ w_o_mla

    y = jax.nn.sigmoid(g_na) * u_na + jax.nn.sigmoid(g_mla) * u_mla
    return x + y @ w_out


def setup_inputs(seed: int = 0) -> dict:
    key = jax.random.key(seed)
    ks = jax.random.split(key, 16)
    f32 = jnp.float32

    def nrm(k, shape, scale):
        return jax.random.normal(k, shape, f32) * scale

    def gain(k, shape):
        return 1.0 + 0.02 * jax.random.normal(k, shape, f32)

    L = DEPTH
    return {
        "x": jax.random.normal(ks[0], (BATCH, SEQ, D_MODEL), f32),
        "ln_g": gain(ks[1], (L, D_MODEL)),
        "w_in": nrm(ks[2], (L, D_MODEL, D_IN), D_MODEL ** -0.5),
        "na_q_norm": gain(ks[3], (L, NA_HEAD_DIM)),
        "na_k_norm": gain(ks[4], (L, NA_HEAD_DIM)),
        "na_rel_bias": nrm(ks[5], (L, NA_HEADS, 2 * NA_WIN_ROWS - 1, 2 * NA_WIN_COLS - 1), 0.5),
        "mla_cq_norm": gain(ks[6], (L, MLA_Q_LORA)),
        "mla_ckv_norm": gain(ks[7], (L, MLA_KV_LORA)),
        "w_uq": nrm(ks[8], (L, MLA_Q_LORA, MLA_HEADS * MLA_QK_DIM), MLA_Q_LORA ** -0.5),
        "w_ukv": nrm(ks[9], (L, MLA_KV_LORA, MLA_HEADS * (MLA_NOPE + MLA_V)), MLA_KV_LORA ** -0.5),
        "mla_q_norm": gain(ks[10], (L, MLA_QK_DIM)),
        "mla_k_norm": gain(ks[11], (L, MLA_QK_DIM)),
        "w_o_na": nrm(ks[12], (L, NA_WIDTH, D_MODEL), NA_WIDTH ** -0.5),
        "w_o_mla": nrm(ks[13], (L, MLA_WIDTH, D_MODEL), MLA_WIDTH ** -0.5),
        "w_out": nrm(ks[14], (L, D_MODEL, D_MODEL), D_MODEL ** -0.5),
    }


def reference(x, ln_g, w_in, na_q_norm, na_k_norm, na_rel_bias, mla_cq_norm, mla_ckv_norm,
              w_uq, w_ukv, mla_q_norm, mla_k_norm, w_o_na, w_o_mla, w_out):
    rope_cos, rope_sin = axial_rope_tables(x.shape[1])
    for l in range(DEPTH):
        x = hybrid_layer(x, ln_g[l], w_in[l], na_q_norm[l], na_k_norm[l], na_rel_bias[l],
                         mla_cq_norm[l], mla_ckv_norm[l], w_uq[l], w_ukv[l],
                         mla_q_norm[l], mla_k_norm[l], w_o_na[l], w_o_mla[l], w_out[l],
                         rope_cos, rope_sin)
    return x
```

```cpp
#include <hip/hip_runtime.h>
#include <hip/hip_cooperative_groups.h>
#include <cstdio>
#include <cstdint>
namespace cg = cooperative_groups;
namespace pg8 {
#define PG8_LAS __attribute__((address_space(3)))
typedef unsigned short bf16_t;
typedef short bf16x8 __attribute__((ext_vector_type(8)));
typedef float f32x4 __attribute__((ext_vector_type(4)));
typedef unsigned u32x4 __attribute__((ext_vector_type(4)));
constexpr int BM = 256, BK = 64, HALF = 128, HTB = HALF * BK * 2  , STAGE_BYTES = 8 * HTB, NXCD = 8, WGM = 8;

__host__ __device__ __forceinline__ int lds_byte(int r, int c) { const int st = (r >> 4) * 2 + (c >> 5), rr = r & 15, cc = c & 31, ob = rr * 64 + cc * 2; return st * 1024 + (ob ^ (((ob >> 9) & 1) << 5)); }
__host__ __device__ __forceinline__ void stage_rc(int b, int& R, int& C) { const int st = b / 1024, sb = b % 1024, swz = sb ^ (((sb >> 9) & 1) << 5); R = (st >> 1) * 16 + swz / 64; C = (st & 1) * 32 + (swz % 64) / 2; }
__host__ __device__ __forceinline__ int perm32(int rho) { const int n = rho >> 4, i = rho & 15; return 8 * (i >> 2) + 4 * n + (i & 3); }

struct Unit { int pm, pn; };
struct Gemm { const bf16_t* A; const bf16_t* Bt; int M, N, K; };

struct StaticOrder {
    int nM, nN, nwg, G, c;
    __host__ __device__ void init(int M, int N, int G_, int c_) { nM = M / BM; nN = N / BM; nwg = nM * nN; G = G_; c = c_; }
    __host__ __device__ bool next(int i, Unit& u) const {
        const long L = (long)i * G + c; if (L >= nwg) return false;
        int wgid = (int)L; { const int q = nwg / NXCD, r = nwg % NXCD, xcd = wgid % NXCD, off = wgid / NXCD; wgid = (xcd < r ? xcd * (q + 1) : r * (q + 1) + (xcd - r) * q) + off; }
        const int nig = WGM * nN, gid = wgid / nig, fm = gid * WGM, gsz = (nM - fm) < WGM ? (nM - fm) : WGM;
        u.pm = fm + ((wgid % nig) % gsz); u.pn = (wgid % nig) / gsz; return true;
    }
    __device__ __forceinline__ void a_ready(const Unit&) const {}
    __device__ __forceinline__ void done(const Unit&) const {}
};
__device__ __forceinline__ unsigned cvt_pk_bf16(float lo, float hi) { unsigned r; asm volatile("v_cvt_pk_bf16_f32 %0, %1, %2" : "=v"(r) : "v"(lo), "v"(hi)); return r; }
typedef float f32x2 __attribute__((ext_vector_type(2)));
template <class Epi, class Sched, bool ALIGN_EPI = false, bool SP2 = false>
__device__ __forceinline__ void gemm_phase(PG8_LAS unsigned char* lds, const Gemm g, const Sched& S, const Epi& E) {
    int tid = threadIdx.x; asm volatile("" : "+v"(tid));
    const int wid = __builtin_amdgcn_readfirstlane(tid >> 6), lane = tid & 63, wr = wid >> 2, wc = wid & 3, fr = lane & 15, fq = lane >> 4;
    const int K = g.K, nt = K / BK;
    unsigned voffA[2], voffB[2];
#pragma unroll
    for (int i = 0; i < 2; ++i) { int R, C; stage_rc(tid * 16 + i * 8192, R, C); const int Rb = Epi::PERM ? ((R & ~31) + perm32(R & 31)) : R;
        voffA[i] = (unsigned)(R * K + C) * 2u; voffB[i] = (unsigned)(Rb * K + C) * 2u; }
    const size_t kstep = (size_t)(BK * 2);
    const size_t hstep = (size_t)HALF * K * 2;
    const size_t tstep = 2 * hstep;
    const unsigned ldsw = (unsigned)wid * 1024u;
    const int aoff = lds_byte(wr * 64 + fr, fq * 8), boff = lds_byte(wc * 32 + fr, fq * 8);
#define PG8_SA(b, h) (((b) * 2 + (h)) * HTB)
#define PG8_SB(b, h) ((4 + (b) * 2 + (h)) * HTB)
#define PG8_STAGE(bufoff, gbase, voff) do { _Pragma("unroll") for (int _i = 0; _i < 2; ++_i) \
        __builtin_amdgcn_global_load_lds((const unsigned*)((const char*)(gbase) + (voff)[_i]), (PG8_LAS unsigned*)(lds + (bufoff) + ldsw + _i * 8192), 16, 0, 0); } while (0)
#define PG8_LDA(dst, b, h) do { _Pragma("unroll") for (int m = 0; m < 4; ++m) _Pragma("unroll") for (int k = 0; k < 2; ++k) dst[m][k] = *(const PG8_LAS bf16x8*)(lds + PG8_SA(b, h) + aoff + m * 2048 + k * 1024); } while (0)
#define PG8_LDB(dst, b, h) do { _Pragma("unroll") for (int n = 0; n < 2; ++n) _Pragma("unroll") for (int k = 0; k < 2; ++k) dst[n][k] = *(const PG8_LAS bf16x8*)(lds + PG8_SB(b, h) + boff + n * 2048 + k * 1024); } while (0)
#define PG8_MMA(ai, bj, At, Bt) do { __builtin_amdgcn_s_setprio(1); _Pragma("unroll") for (int m = 0; m < 4; ++m) _Pragma("unroll") for (int n = 0; n < 2; ++n) _Pragma("unroll") for (int k = 0; k < 2; ++k) \
        acc[ai][bj][m][n] = __builtin_amdgcn_mfma_f32_16x16x32_bf16(Bt[n][k], At[m][k], acc[ai][bj][m][n], 0, 0, 0); __builtin_amdgcn_s_setprio(0); } while (0)
#define PG8_WAIT_V(n) asm volatile("s_waitcnt vmcnt(" #n ")" ::: "memory")
#define PG8_WAIT_L(n) asm volatile("s_waitcnt lgkmcnt(" #n ")" ::: "memory")
#define PG8_BAR __builtin_amdgcn_s_barrier()
#define PG8_SCHED __builtin_amdgcn_sched_barrier(0)
    Unit cur, nxt; int ui = 0;
    if (!S.next(0, cur)) return;
    f32x4 acc[2][2][4][2];
#pragma unroll
    for (int a = 0; a < 2; ++a)
#pragma unroll
        for (int b = 0; b < 2; ++b)
#pragma unroll
            for (int m = 0; m < 4; ++m)
#pragma unroll
                for (int n = 0; n < 2; ++n) acc[a][b][m][n] = (f32x4){0.f, 0.f, 0.f, 0.f};
    bf16x8 At[4][2], B0[2][2], B1[2][2];
    const char* cA = (const char*)g.A + (size_t)cur.pm * tstep; const char* cB = (const char*)g.Bt + (size_t)cur.pn * tstep;
    S.a_ready(cur);
    if constexpr (SP2) {
        PG8_STAGE(PG8_SB(0, 0), cB, voffB); PG8_STAGE(PG8_SB(0, 1), cB + hstep, voffB); PG8_STAGE(PG8_SA(0, 0), cA, voffA); PG8_STAGE(PG8_SA(0, 1), cA + hstep, voffA);
        if (wr == 1) PG8_BAR;
        PG8_WAIT_V(2); PG8_BAR;
        PG8_STAGE(PG8_SB(1, 0), cB + kstep, voffB); PG8_STAGE(PG8_SA(1, 0), cA + kstep, voffA); PG8_STAGE(PG8_SB(1, 1), cB + hstep + kstep, voffB);
        PG8_WAIT_V(6); PG8_BAR;
    } else {
        PG8_STAGE(PG8_SB(0, 0), cB, voffB); PG8_STAGE(PG8_SA(0, 0), cA, voffA); PG8_STAGE(PG8_SB(0, 1), cB + hstep, voffB); PG8_STAGE(PG8_SA(0, 1), cA + hstep, voffA);
        if (wr == 1) PG8_BAR;
        PG8_WAIT_V(4); PG8_BAR;
        PG8_STAGE(PG8_SB(1, 0), cB + kstep, voffB); PG8_STAGE(PG8_SA(1, 0), cA + kstep, voffA); PG8_STAGE(PG8_SB(1, 1), cB + hstep + kstep, voffB);
        PG8_WAIT_V(6); PG8_BAR;
    }
    for (;;) {
        const bool has_next = S.next(ui + 1, nxt);
        const char* nA = has_next ? (const char*)g.A + (size_t)nxt.pm * tstep : cA; const char* nB = has_next ? (const char*)g.Bt + (size_t)nxt.pn * tstep : cB;
        for (int t = 0; t < nt; t += 2) {
            const bool last = (t == nt - 2);
            const char* a1 = cA + (size_t)(t + 1) * kstep;
            const char* a2 = last ? nA : cA + (size_t)(t + 2) * kstep; const char* b2 = last ? nB : cB + (size_t)(t + 2) * kstep;
            const char* a3 = a2 + kstep; const char* b3 = b2 + kstep;
            if (last && has_next) S.a_ready(nxt);
            if constexpr (SP2) {
            PG8_LDB(B0, 0, 0); PG8_LDB(B1, 0, 1); PG8_SCHED; PG8_LDA(At, 0, 0); PG8_STAGE(PG8_SA(1, 1), a1 + hstep, voffA);
            PG8_WAIT_V(8); PG8_WAIT_L(0); PG8_BAR; PG8_MMA(0, 0, At, B0); PG8_MMA(0, 1, At, B1); PG8_BAR; PG8_SCHED;
            PG8_LDA(At, 0, 1); PG8_STAGE(PG8_SB(0, 0), b2, voffB); PG8_STAGE(PG8_SB(0, 1), b2 + hstep, voffB); PG8_STAGE(PG8_SA(0, 0), a2, voffA);
            PG8_WAIT_V(8); PG8_WAIT_L(0); PG8_BAR; PG8_MMA(1, 0, At, B0); PG8_MMA(1, 1, At, B1); PG8_BAR; PG8_SCHED;
            PG8_LDB(B0, 1, 0); PG8_LDB(B1, 1, 1); PG8_SCHED; PG8_LDA(At, 1, 0); PG8_STAGE(PG8_SA(0, 1), a2 + hstep, voffA);
            PG8_WAIT_V(8); PG8_WAIT_L(0); PG8_BAR; PG8_MMA(0, 0, At, B0); PG8_MMA(0, 1, At, B1); PG8_BAR; PG8_SCHED;
            PG8_LDA(At, 1, 1); PG8_STAGE(PG8_SB(1, 0), b3, voffB); PG8_STAGE(PG8_SB(1, 1), b3 + hstep, voffB); PG8_STAGE(PG8_SA(1, 0), a3, voffA);
            PG8_WAIT_V(8); PG8_WAIT_L(0); PG8_BAR; PG8_MMA(1, 0, At, B0); PG8_MMA(1, 1, At, B1); PG8_BAR; PG8_SCHED;
            } else {
            PG8_LDB(B0, 0, 0); PG8_SCHED; PG8_LDA(At, 0, 0); PG8_STAGE(PG8_SA(1, 1), a1 + hstep, voffA);
            PG8_WAIT_L(8); PG8_BAR; PG8_WAIT_L(0); PG8_MMA(0, 0, At, B0); PG8_BAR; PG8_SCHED;
            PG8_LDB(B1, 0, 1); PG8_STAGE(PG8_SB(0, 0), b2, voffB);
            PG8_BAR; PG8_WAIT_L(0); PG8_MMA(0, 1, At, B1); PG8_BAR;
            PG8_LDA(At, 0, 1); PG8_STAGE(PG8_SA(0, 0), a2, voffA);
            PG8_BAR; PG8_WAIT_L(0); PG8_MMA(1, 0, At, B0); PG8_BAR; PG8_SCHED;
            PG8_STAGE(PG8_SB(0, 1), b2 + hstep, voffB);
            PG8_WAIT_V(6); PG8_BAR; PG8_MMA(1, 1, At, B1); PG8_BAR;
            PG8_LDB(B0, 1, 0); PG8_SCHED; PG8_LDA(At, 1, 0); PG8_STAGE(PG8_SA(0, 1), a2 + hstep, voffA);
            PG8_WAIT_L(8); PG8_BAR; PG8_WAIT_L(0); PG8_MMA(0, 0, At, B0); PG8_BAR; PG8_SCHED;
            PG8_LDB(B1, 1, 1); PG8_STAGE(PG8_SB(1, 0), b3, voffB);
            PG8_BAR; PG8_WAIT_L(0); PG8_MMA(0, 1, At, B1); PG8_BAR;
            PG8_LDA(At, 1, 1); PG8_STAGE(PG8_SA(1, 0), a3, voffA);
            PG8_BAR; PG8_WAIT_L(0); PG8_MMA(1, 0, At, B0); PG8_BAR; PG8_SCHED;
            PG8_STAGE(PG8_SB(1, 1), b3 + hstep, voffB);
            PG8_WAIT_V(6); PG8_BAR; PG8_MMA(1, 1, At, B1); PG8_BAR;
            }
        }
        if constexpr (ALIGN_EPI) { if (wr == 0) PG8_BAR; }
        if constexpr (!Epi::AFTER_DRAIN) { E(acc, cur, wr, wc, fr, fq); S.done(cur); }
        if (!has_next) break;
#pragma unroll
        for (int a = 0; a < 2; ++a)
#pragma unroll
            for (int b = 0; b < 2; ++b)
#pragma unroll
                for (int m = 0; m < 4; ++m)
#pragma unroll
                    for (int n = 0; n < 2; ++n) acc[a][b][m][n] = (f32x4){0.f, 0.f, 0.f, 0.f};
        cur = nxt; cA = nA; cB = nB; ++ui;
        if constexpr (ALIGN_EPI) { if (wr == 1) PG8_BAR; }
    }
    PG8_WAIT_V(0);
    if constexpr (!ALIGN_EPI) { if (wr == 0) PG8_BAR; }
    PG8_BAR;
    if constexpr (Epi::AFTER_DRAIN) { E.fused(acc, cur, wr, wc, fr, fq, lds, wid, lane); S.done(cur); }
#undef PG8_SA
#undef PG8_SB
#undef PG8_STAGE
#undef PG8_LDA
#undef PG8_LDB
#undef PG8_MMA
#undef PG8_WAIT_V
#undef PG8_WAIT_L
#undef PG8_BAR
#undef PG8_SCHED
}
}

#define LAS __attribute__((address_space(3)))
typedef unsigned short bf16_t;
typedef short bf16x8 __attribute__((ext_vector_type(8)));
typedef float f32x4 __attribute__((ext_vector_type(4)));
typedef float f32x2 __attribute__((ext_vector_type(2)));
typedef float f32x16 __attribute__((ext_vector_type(16)));
typedef unsigned u32x4 __attribute__((ext_vector_type(4)));
typedef unsigned u32x2 __attribute__((ext_vector_type(2)));
using pg8::Unit; using pg8::cvt_pk_bf16;

constexpr int MTOK = 65536, SEQ = 4096, NLAYER = 4, NIN = 5120, DIN = 5024;
constexpr float EPS = 1e-6f, LOG2E = 1.4426950408889634f;
constexpr float QSC_NA = 0.125f * LOG2E;
constexpr float QSC_MLA = 0.10206207261596575f * LOG2E;

constexpr size_t MiB = 1u << 20;
constexpr size_t WS_WIN = 0, WS_WUQ = 40 * MiB, WS_WUKV = 42 * MiB, WS_WONA = 44 * MiB, WS_WOMLA = 48 * MiB, WS_WOUT = 52 * MiB,
    WS_COS = 60 * MiB, WS_SIN = 60 * MiB + 512 * 1024, WS_BND = 61 * MiB, WS_RSX = 62 * MiB, WS_KPESS = 62 * MiB + 256 * 1024, WS_SSKV = 62 * MiB + 512 * 1024,
    WS_SSQ = 63 * MiB, WS_RPE = 64 * MiB, WS_QSS = 72 * MiB, WS_CQ = 78 * MiB, WS_CKV = 110 * MiB, WS_XB = 142 * MiB, WS_QNA = 270 * MiB,
    WS_KNA = 334 * MiB, WS_VTNA = 398 * MiB, WS_GA = 462 * MiB, WS_OMLA = WS_KNA  , WS_GM = 526 * MiB, WS_SGA = 590 * MiB, WS_SGM = 718 * MiB,
    WS_KMLA = 846 * MiB, WS_VTMLA = 942 * MiB, WS_Y = WS_KMLA  , WS_END = 1006 * MiB;
constexpr int LDS_BYTES = 131072 + 1024;

__device__ __forceinline__ float bflo(unsigned w) { return __uint_as_float(w << 16); }
__device__ __forceinline__ float bfhi(unsigned w) { return __uint_as_float(w & 0xffff0000u); }
__device__ __forceinline__ f32x4 unpk4(unsigned a, unsigned b) { return (f32x4){bflo(a), bfhi(a), bflo(b), bfhi(b)}; }
__device__ __forceinline__ u32x4 pack8(f32x4 a, f32x4 b) { u32x4 w; w.x = cvt_pk_bf16(a[0], a[1]); w.y = cvt_pk_bf16(a[2], a[3]); w.z = cvt_pk_bf16(b[0], b[1]); w.w = cvt_pk_bf16(b[2], b[3]); return w; }
__device__ __forceinline__ unsigned pk4_fp8(float a, float b, float c, float d) { int w = 0; w = __builtin_amdgcn_cvt_pk_fp8_f32(a, b, w, false); w = __builtin_amdgcn_cvt_pk_fp8_f32(c, d, w, true); return (unsigned)w; }
__device__ __forceinline__ u32x2 pack8_fp8(f32x4 a, f32x4 b) { u32x2 w; w.x = pk4_fp8(a[0], a[1], a[2], a[3]); w.y = pk4_fp8(b[0], b[1], b[2], b[3]); return w; }
__device__ __forceinline__ float rsqf(float x) { return __builtin_amdgcn_rsqf(x); }
__device__ __forceinline__ float sig1(float x) { return __builtin_amdgcn_rcpf(1.f + __builtin_amdgcn_exp2f(-LOG2E * x)); }
__device__ __forceinline__ f32x4 sig4(f32x4 v) { return (f32x4){sig1(v[0]), sig1(v[1]), sig1(v[2]), sig1(v[3])}; }
__device__ __forceinline__ f32x4 silu4(f32x4 v) { return v * sig4(v); }
__device__ __forceinline__ float dot4(f32x4 v) { return (v[0] * v[0] + v[1] * v[1]) + (v[2] * v[2] + v[3] * v[3]); }
__device__ __forceinline__ float red4(float s) { s += __shfl_xor(s, 16); s += __shfl_xor(s, 32); return s; }
__device__ __forceinline__ int opq(int v) { asm volatile("" : "+s"(v)); return v; }
__device__ __forceinline__ int perm16(int f) { return (f & 3) | ((f & 8) >> 1) | ((f & 4) << 1); }

#define FOR_AI_M _Pragma("unroll") for (int ai = 0; ai < 2; ++ai) _Pragma("unroll") for (int m = 0; m < 4; ++m)
#define ROWFENCE asm volatile("" ::: "memory")
#define FOR_BJ _Pragma("unroll") for (int bj = 0; bj < 2; ++bj)

template <int ACT  >
__device__ __forceinline__ void store_rows(bf16_t* base, int ld, int col0, const f32x4 (&acc)[2][2][4][2], const float (&rs)[2][4], int rowb, int c8) {
    FOR_AI_M { ROWFENCE; int row = rowb + ai * 128 + m * 16; asm volatile("" : "+v"(row)); const float r0 = rs[ai][m]; bf16_t* dst = base + (size_t)row * ld + col0 + c8;
        FOR_BJ {
            if (ACT == 2) {
                const float cr = -LOG2E * r0;
                f32x4 a = acc[ai][bj][m][0] * cr, b = acc[ai][bj][m][1] * cr;
                a = (f32x4){__builtin_amdgcn_exp2f(a[0]), __builtin_amdgcn_exp2f(a[1]), __builtin_amdgcn_exp2f(a[2]), __builtin_amdgcn_exp2f(a[3])} * (1.f / 255.f) + (1.f / 255.f);
                b = (f32x4){__builtin_amdgcn_exp2f(b[0]), __builtin_amdgcn_exp2f(b[1]), __builtin_amdgcn_exp2f(b[2]), __builtin_amdgcn_exp2f(b[3])} * (1.f / 255.f) + (1.f / 255.f);
                int qx = __builtin_amdgcn_cvt_pk_u8_f32(__builtin_amdgcn_rcpf(a[0]), 0, 0); qx = __builtin_amdgcn_cvt_pk_u8_f32(__builtin_amdgcn_rcpf(a[1]), 1, qx);
                qx = __builtin_amdgcn_cvt_pk_u8_f32(__builtin_amdgcn_rcpf(a[2]), 2, qx); qx = __builtin_amdgcn_cvt_pk_u8_f32(__builtin_amdgcn_rcpf(a[3]), 3, qx);
                int qy = __builtin_amdgcn_cvt_pk_u8_f32(__builtin_amdgcn_rcpf(b[0]), 0, 0); qy = __builtin_amdgcn_cvt_pk_u8_f32(__builtin_amdgcn_rcpf(b[1]), 1, qy);
                qy = __builtin_amdgcn_cvt_pk_u8_f32(__builtin_amdgcn_rcpf(b[2]), 2, qy); qy = __builtin_amdgcn_cvt_pk_u8_f32(__builtin_amdgcn_rcpf(b[3]), 3, qy);
                u32x2 q; q.x = (unsigned)qx; q.y = (unsigned)qy;
                *(u32x2*)((unsigned char*)base + (size_t)row * ld + col0 + c8 + 32 * bj) = q;
            } else { f32x4 a = acc[ai][bj][m][0] * r0, b = acc[ai][bj][m][1] * r0;
                if (ACT == 1) { a = silu4(a); b = silu4(b); }
                *(u32x4*)(dst + 32 * bj) = pack8(a, b); } } }
}
__device__ __forceinline__ void store_vt(bf16_t* vt_head  , int sp, f32x4 v, int dv) {
    const unsigned w0 = cvt_pk_bf16(v[0], v[1]), w1 = cvt_pk_bf16(v[2], v[3]);
    bf16_t* d = vt_head + (size_t)dv * 4096 + sp;
    d[0] = (bf16_t)(w0 & 0xffffu); d[4096] = (bf16_t)(w0 >> 16); d[8192] = (bf16_t)(w1 & 0xffffu); d[12288] = (bf16_t)(w1 >> 16);
}

struct EpiInProj {
    static constexpr bool PERM = true, AFTER_DRAIN = false;
    const float* rsx; const float* gq; const float* gk; const float* gkm; const float* cosT; const float* sinT;
    bf16_t *QNA, *KNA, *VTNA, *GA, *CQ, *CKV, *GM, *SGA, *SGM; float *SSQ, *SSKV, *KPESS, *RPE;
    __device__ __forceinline__ void operator()(const f32x4 (&acc)[2][2][4][2], const Unit& u, int wr, int wc, int fr_, int fq_) const {
        int fr = fr_, fq = fq_; asm volatile("" : "+v"(fr), "+v"(fq));
        const int pn = u.pn, rowb = u.pm * 256 + wr * 64 + fr, c8 = 8 * fq;
        float rs[2][4];
        FOR_AI_M rs[ai][m] = rsqf(rsx[rowb + ai * 128 + m * 16] * (1.f / 1024.f) + EPS);
        if (pn < 4) {
            const bool isq = pn < 2; const int h = (pn & 1) * 4 + wc; const float* g = isq ? gq : gk; const float gs = isq ? QSC_NA : 1.f;
            f32x4 gv[2][2];
            FOR_BJ { gv[bj][0] = *(const f32x4*)(g + 32 * bj + c8) * gs; gv[bj][1] = *(const f32x4*)(g + 32 * bj + c8 + 4) * gs; }
            FOR_AI_M { ROWFENCE; int row = rowb + ai * 128 + m * 16; asm volatile("" : "+v"(row)); const float r0 = rs[ai][m];
                f32x4 v[2][2]; float ss = 0.f;
                FOR_BJ { v[bj][0] = acc[ai][bj][m][0] * r0; v[bj][1] = acc[ai][bj][m][1] * r0; ss += dot4(v[bj][0]) + dot4(v[bj][1]); }
                ss = red4(ss); const float rstd = rsqf(ss * (1.f / 64.f) + EPS);
                bf16_t* dst = isq ? QNA + (size_t)row * 512 + 64 * h + c8 : KNA + ((size_t)((row >> 12) * 8 + h) * 4096 + (row & 4095)) * 64 + c8;
                FOR_BJ *(u32x4*)(dst + 32 * bj) = pack8(v[bj][0] * rstd * gv[bj][0], v[bj][1] * rstd * gv[bj][1]); }
        } else if (pn < 6) {
            const int h = (pn - 4) * 4 + wc;
            FOR_AI_M { ROWFENCE; int row = rowb + ai * 128 + m * 16; asm volatile("" : "+v"(row)); const float r0 = rs[ai][m];
                bf16_t* dst = VTNA + ((size_t)((row >> 12) * 8 + h) * 4096 + (row & 4095)) * 64 + c8;
                FOR_BJ *(u32x4*)(dst + 32 * bj) = pack8(acc[ai][bj][m][0] * r0, acc[ai][bj][m][1] * r0); }
        } else if (pn < 8) { store_rows<1>(GA, 512, 64 * ((pn - 6) * 4 + wc), acc, rs, rowb, c8);
        } else if (pn == 8) {
            FOR_AI_M { ROWFENCE; int row = rowb + ai * 128 + m * 16; asm volatile("" : "+v"(row)); const float r0 = rs[ai][m]; float ss = 0.f;
                FOR_BJ { const f32x4 a = acc[ai][bj][m][0] * r0, b = acc[ai][bj][m][1] * r0; ss += dot4(a) + dot4(b);
                    *(u32x4*)(CQ + (size_t)row * 256 + 64 * wc + 32 * bj + c8) = pack8(a, b); }
                ss = red4(ss); if (fq == 0) SSQ[(size_t)row * 4 + wc] = ss; }
        } else if (pn == 9) {
            FOR_AI_M { ROWFENCE; int row = rowb + ai * 128 + m * 16; asm volatile("" : "+v"(row)); const float r0 = rs[ai][m];
                if (wc < 2) { float ss = 0.f;
                    FOR_BJ { const f32x4 a = acc[ai][bj][m][0] * r0, b = acc[ai][bj][m][1] * r0; ss += dot4(a) + dot4(b);
                        *(u32x4*)(CKV + (size_t)row * 256 + 64 * wc + 32 * bj + c8) = pack8(a, b); }
                    ss = red4(ss); if (fq == 0) SSKV[(size_t)row * 2 + wc] = ss;
                } else {
                    FOR_BJ *(u32x4*)(CKV + (size_t)row * 256 + 64 * wc + 32 * bj + c8) = (u32x4){0u, 0u, 0u, 0u};
                    if (wc == 2) {
                        const f32x4 a = acc[ai][0][m][0] * r0, b = acc[ai][0][m][1] * r0;
                        float ss = red4(dot4(a) + dot4(b)); if (fq == 0) KPESS[row] = ss;
                        const f32x4 ga = a * *(const f32x4*)(gkm + 64 + c8), gb = b * *(const f32x4*)(gkm + 64 + c8 + 4);
                        f32x4 pa, pb;
#pragma unroll
                        for (int e = 0; e < 4; ++e) { pa[e] = __shfl_xor(ga[e], 32); pb[e] = __shfl_xor(gb[e], 32); }
                        const int ti = (row & 4095) * 16 + 8 * (fq & 1);
                        const f32x4 ca = *(const f32x4*)(cosT + ti), cb = *(const f32x4*)(cosT + ti + 4), sa = *(const f32x4*)(sinT + ti), sb = *(const f32x4*)(sinT + ti + 4);
                        f32x4 oa, ob;
                        if (fq < 2) { oa = ga * ca - pa * sa; ob = gb * cb - pb * sb; }
                        else        { oa = pa * sa + ga * ca; ob = pb * sb + gb * cb; }
                        *(f32x4*)(RPE + (size_t)row * 32 + c8) = oa; *(f32x4*)(RPE + (size_t)row * 32 + c8 + 4) = ob;
                    }
                } }
        } else if (pn < 12) { store_rows<1>(GM, 512, 64 * ((pn - 10) * 4 + wc), acc, rs, rowb, c8);
        } else if (pn < 16) { store_rows<2>(SGA, 1024, 256 * (pn - 12) + 64 * wc, acc, rs, rowb, c8);
        } else { store_rows<2>(SGM, 1024, 256 * (pn - 16) + 64 * wc, acc, rs, rowb, c8); }
    }
};

struct EpiUQ {
    static constexpr bool PERM = true, AFTER_DRAIN = false;
    const float* SSQ; bf16_t* QR; float* QSS;
    __device__ __forceinline__ void operator()(const f32x4 (&acc)[2][2][4][2], const Unit& u, int wr, int wc, int fr_, int fq_) const {
        int fr = fr_, fq = fq_; asm volatile("" : "+v"(fr), "+v"(fq));
        const int pn = u.pn, rowb = u.pm * 256 + wr * 64 + fr, c8 = 8 * fq;
        f32x4 s4a[2][4];
        FOR_AI_M s4a[ai][m] = *(const f32x4*)(SSQ + (size_t)(rowb + ai * 128 + m * 16) * 4);
        FOR_AI_M { ROWFENCE; int row = rowb + ai * 128 + m * 16; asm volatile("" : "+v"(row)); const f32x4 s4 = s4a[ai][m];
            const float r0 = rsqf(((s4[0] + s4[1]) + (s4[2] + s4[3])) * (1.f / 256.f) + EPS);
            FOR_BJ { const f32x4 a = acc[ai][bj][m][0] * r0, b = acc[ai][bj][m][1] * r0; const float ss = red4(dot4(a) + dot4(b));
                *(u32x4*)(QR + (size_t)row * 768 + 256 * pn + 64 * wc + 32 * bj + c8) = pack8(a, b);
                if (fq == 0) QSS[(size_t)row * 24 + 8 * pn + 2 * wc + bj] = ss; } }
    }
};

struct EpiKV {
    static constexpr bool PERM = true, AFTER_DRAIN = false;
    const float* SSKV; const float* KPESS; const float* RPE; const float* gkm; bf16_t* KM; bf16_t* VTM;
    __device__ __forceinline__ void operator()(const f32x4 (&acc)[2][2][4][2], const Unit& u, int wr, int wc, int fr_, int fq_) const {
        int fr = fr_, fq = fq_; asm volatile("" : "+v"(fr), "+v"(fq));
        const int chunk = 4 * u.pn + wc, h = chunk >> 1, rowb = u.pm * 256 + wr * 64 + fr, c8 = 8 * fq; const bool isv = chunk & 1;
        f32x4 gv[2][2];
        FOR_BJ { gv[bj][0] = *(const f32x4*)(gkm + 32 * bj + c8); gv[bj][1] = *(const f32x4*)(gkm + 32 * bj + c8 + 4); }
        f32x2 s2a[2][4]; float kpa[2][4];
        FOR_AI_M { s2a[ai][m] = *(const f32x2*)(SSKV + (size_t)(rowb + ai * 128 + m * 16) * 2); kpa[ai][m] = KPESS[rowb + ai * 128 + m * 16]; }
        FOR_AI_M { ROWFENCE; int row = rowb + ai * 128 + m * 16; asm volatile("" : "+v"(row)); const f32x2 s2 = s2a[ai][m];
            const float r0 = rsqf((s2[0] + s2[1]) * (1.f / 128.f) + EPS); const int b = row >> 12, s = row & 4095;
            if (!isv) {
                f32x4 v[2][2]; float ss = 0.f;
                FOR_BJ { v[bj][0] = acc[ai][bj][m][0] * r0; v[bj][1] = acc[ai][bj][m][1] * r0; ss += dot4(v[bj][0]) + dot4(v[bj][1]); }
                ss = red4(ss) + kpa[ai][m]; const float rstd = rsqf(ss * (1.f / 96.f) + EPS);
                unsigned char* dst = (unsigned char*)KM + ((size_t)(b * 8 + h) * 4096 + s) * 128;
                FOR_BJ *(u32x2*)(dst + 32 * bj + c8) = pack8_fp8(v[bj][0] * rstd * gv[bj][0], v[bj][1] * rstd * gv[bj][1]);
                const f32x4 ra = *(const f32x4*)(RPE + (size_t)row * 32 + c8), rb = *(const f32x4*)(RPE + (size_t)row * 32 + c8 + 4);
                *(u32x2*)(dst + 64 + c8) = pack8_fp8(ra * rstd, rb * rstd);
                *(u32x2*)(dst + 96 + c8) = (u32x2){0u, 0u};
            } else {
                bf16_t* dst = VTM + ((size_t)(b * 8 + h) * 4096 + s) * 64 + c8;
                FOR_BJ *(u32x4*)(dst + 32 * bj) = pack8(acc[ai][bj][m][0] * r0, acc[ai][bj][m][1] * r0);
            } }
    }
};

template <int SECOND> struct EpiY {
    static constexpr bool PERM = true, AFTER_DRAIN = false;
    const bf16_t* SG; bf16_t* Y;
    __device__ __forceinline__ void operator()(const f32x4 (&acc)[2][2][4][2], const Unit& u, int wr, int wc, int fr_, int fq_) const {
        int fr = fr_, fq = fq_; asm volatile("" : "+v"(fr), "+v"(fq));
        const int rowb = u.pm * 256 + wr * 64 + fr, c8 = 8 * fq, colb = 256 * u.pn + 64 * wc + c8;
        u32x2 ga_[2][4][2];
        FOR_AI_M FOR_BJ ga_[ai][m][bj] = *(const u32x2*)((const unsigned char*)SG + (size_t)(rowb + ai * 128 + m * 16) * 1024 + colb + 32 * bj);
#pragma unroll
        for (int ai = 0; ai < 2; ++ai)
#pragma unroll
        for (int mh = 0; mh < 2; ++mh) {
        u32x4 yo_[4][2];
        if (SECOND) {
#pragma unroll
            for (int m = 2 * mh; m < 2 * mh + 2; ++m) FOR_BJ yo_[m][bj] = *(const u32x4*)(Y + (size_t)(rowb + ai * 128 + m * 16) * 1024 + colb + 32 * bj); }
#pragma unroll
        for (int m = 2 * mh; m < 2 * mh + 2; ++m) { ROWFENCE; int row = rowb + ai * 128 + m * 16; asm volatile("" : "+v"(row));
            FOR_BJ { const size_t off = (size_t)row * 1024 + colb + 32 * bj; const u32x2 g = ga_[ai][m][bj];
                const f32x4 ga = (f32x4){(float)(g.x & 0xffu), (float)((g.x >> 8) & 0xffu), (float)((g.x >> 16) & 0xffu), (float)(g.x >> 24)} * (1.f / 255.f);
                const f32x4 gb = (f32x4){(float)(g.y & 0xffu), (float)((g.y >> 8) & 0xffu), (float)((g.y >> 16) & 0xffu), (float)(g.y >> 24)} * (1.f / 255.f);
                f32x4 a = acc[ai][bj][m][0] * ga, b = acc[ai][bj][m][1] * gb;
                if (SECOND) { const u32x4 y = yo_[m][bj]; a += unpk4(y.x, y.y); b += unpk4(y.z, y.w); }
                *(u32x4*)(Y + off) = pack8(a, b); } } }
    }
};

struct PairOrder {
    pg8::StaticOrder base;
    __device__ __forceinline__ bool next(int i, Unit& u) const { if (!base.next(i >> 1, u)) return false; if (i & 1) { u.pm += 256; u.pn += 16; } return true; }
    __device__ __forceinline__ void a_ready(const Unit&) const {}
    __device__ __forceinline__ void done(const Unit&) const {}
};
struct EpiYP {
    static constexpr bool PERM = true, AFTER_DRAIN = false;
    const bf16_t* SGA_; const bf16_t* SGM_; bf16_t* Y;
    __device__ __forceinline__ void operator()(const f32x4 (&acc)[2][2][4][2], const Unit& u, int wr, int wc, int fr_, int fq_) const {
        int fr = fr_, fq = fq_; asm volatile("" : "+v"(fr), "+v"(fq));
        const bool second = u.pm >= 256; const int pm = second ? u.pm - 256 : u.pm, pn = second ? u.pn - 16 : u.pn; const bf16_t* SG = second ? SGM_ : SGA_;
        const int rowb = pm * 256 + wr * 64 + fr, c8 = 8 * fq, colb = 256 * pn + 64 * wc + c8;
        u32x2 ga_[2][4][2];
        FOR_AI_M FOR_BJ ga_[ai][m][bj] = *(const u32x2*)((const unsigned char*)SG + (size_t)(rowb + ai * 128 + m * 16) * 1024 + colb + 32 * bj);
#pragma unroll
        for (int ai = 0; ai < 2; ++ai)
#pragma unroll
        for (int mh = 0; mh < 2; ++mh) {
        u32x4 yo_[4][2];
#pragma unroll
        for (int m = 2 * mh; m < 2 * mh + 2; ++m) FOR_BJ yo_[m][bj] = second ? *(const u32x4*)(Y + (size_t)(rowb + ai * 128 + m * 16) * 1024 + colb + 32 * bj) : (u32x4){0u, 0u, 0u, 0u};
#pragma unroll
        for (int m = 2 * mh; m < 2 * mh + 2; ++m) { ROWFENCE; int row = rowb + ai * 128 + m * 16; asm volatile("" : "+v"(row));
            FOR_BJ { const size_t off = (size_t)row * 1024 + colb + 32 * bj; const u32x2 g = ga_[ai][m][bj];
                const f32x4 ga = (f32x4){(float)(g.x & 0xffu), (float)((g.x >> 8) & 0xffu), (float)((g.x >> 16) & 0xffu), (float)(g.x >> 24)} * (1.f / 255.f);
                const f32x4 gb = (f32x4){(float)(g.y & 0xffu), (float)((g.y >> 8) & 0xffu), (float)((g.y >> 16) & 0xffu), (float)(g.y >> 24)} * (1.f / 255.f);
                const u32x4 y = yo_[m][bj];
                const f32x4 a = acc[ai][bj][m][0] * ga + unpk4(y.x, y.y), b = acc[ai][bj][m][1] * gb + unpk4(y.z, y.w);
                *(u32x4*)(Y + off) = pack8(a, b); } } }
    }
};
struct UqKvOrder {
    pg8::StaticOrder uq, kv; int nuq, kvtile;
    __device__ __forceinline__ bool next(int i, Unit& u) const {
        if (i < nuq) return uq.next(i, u);
        if (!kv.next(i - nuq, u)) return false; u.pm += 256; u.pn += kvtile; return true; }
    __device__ __forceinline__ void a_ready(const Unit&) const {}
    __device__ __forceinline__ void done(const Unit&) const {}
};
struct EpiUqKv {
    static constexpr bool PERM = true, AFTER_DRAIN = false;
    EpiUQ q; EpiKV k; int kvtile;
    __device__ __forceinline__ void operator()(const f32x4 (&acc)[2][2][4][2], const Unit& u, int wr, int wc, int fr, int fq) const {
        if (u.pm >= 256) { Unit v; v.pm = u.pm - 256; v.pn = u.pn - kvtile; k(acc, v, wr, wc, fr, fq); } else q(acc, u, wr, wc, fr, fq);
    }
};
struct EpiOut {
    static constexpr bool PERM = true, AFTER_DRAIN = false;
    const float* xin; float* xout; bf16_t* XB; float* RSX; int last;
    __device__ __forceinline__ void operator()(const f32x4 (&acc)[2][2][4][2], const Unit& u, int wr, int wc, int fr_, int fq_) const {
        int fr = fr_, fq = fq_; asm volatile("" : "+v"(fr), "+v"(fq));
        const int rowb = u.pm * 256 + wr * 64 + fr, c8 = 8 * fq, colb = 256 * u.pn + 64 * wc + c8;
#pragma unroll
        for (int ai = 0; ai < 2; ++ai)
#pragma unroll
        for (int mh = 0; mh < 2; ++mh) {
        f32x4 xa_[4][2][2];
#pragma unroll
        for (int m = 2 * mh; m < 2 * mh + 2; ++m) FOR_BJ { const float* xp = xin + (size_t)(rowb + ai * 128 + m * 16) * 1024 + colb + 32 * bj; xa_[m][bj][0] = *(const f32x4*)xp; xa_[m][bj][1] = *(const f32x4*)(xp + 4); }
#pragma unroll
        for (int m = 2 * mh; m < 2 * mh + 2; ++m) { ROWFENCE; int row = rowb + ai * 128 + m * 16; asm volatile("" : "+v"(row)); float ss = 0.f;
            FOR_BJ { const size_t off = (size_t)row * 1024 + colb + 32 * bj;
                const f32x4 a = xa_[m][bj][0] + acc[ai][bj][m][0], b = xa_[m][bj][1] + acc[ai][bj][m][1];
                *(f32x4*)(xout + off) = a; *(f32x4*)(xout + off + 4) = b; if (!last) *(u32x4*)(XB + off) = pack8(a, b); ss += dot4(a) + dot4(b); }
            ss = red4(ss); if (fq == 0 && !last) atomicAdd(RSX + row, ss); } }
    }
};

struct AttnP { const bf16_t* Q; const bf16_t* K; const bf16_t* VT; const bf16_t* G; bf16_t* O; const float* QSS; const float* gq; const float* cosT; const float* sinT; const float* bias; };

#ifndef NA_STATIC_SKIP
#define NA_STATIC_SKIP 3
#endif
template <bool ISNA, int QB>
__device__ __forceinline__ void att_softmax(f32x16& p0, f32x16& p1, float& lsum, LAS const unsigned char* tb, int dval) {
    if (ISNA) {
#pragma unroll
        for (int r = 0; r < 16; ++r) { const int jc0 = (r & 3) + 8 * (r >> 2), jc1 = jc0 + 32;
            if ((NA_STATIC_SKIP & 2) && QB == 1 && r < 12) p0[r] = 0.f;
            else { const float e0 = __builtin_amdgcn_exp2f(p0[r] + *(LAS const float*)(tb + 4 * jc0)); p0[r] = __uint_as_float(__float_as_uint(e0) & (unsigned)__builtin_amdgcn_sbfe(dval, r, 1)); }
            if ((NA_STATIC_SKIP & 1) && QB == 0 && r >= 4) p1[r] = 0.f;
            else { const float e1 = __builtin_amdgcn_exp2f(p1[r] + *(LAS const float*)(tb + 4 * jc1)); p1[r] = __uint_as_float(__float_as_uint(e1) & (unsigned)__builtin_amdgcn_sbfe(dval, 16 + r, 1)); } }
    } else {
#pragma unroll
        for (int r = 0; r < 16; ++r) { p0[r] = __builtin_amdgcn_exp2f(p0[r]); p1[r] = __builtin_amdgcn_exp2f(p1[r]); }
    }
    float sa = 0.f, sb = 0.f;
#pragma unroll
    for (int r = 0; r < 16; ++r) { sa += p0[r]; sb += p1[r]; }
    lsum += sa + sb;
}
template <int DK, bool ISNA>
__device__ __forceinline__ void att_load_q(const AttnP& P, size_t row, int qtok, int h, int hi, bf16x8 (&qf)[DK / 16]) {
    constexpr int ND = DK / 16;
    if (ISNA) {
        const bf16_t* qp = P.Q + row * 512 + h * 64 + hi * 8;
#pragma unroll
        for (int d0 = 0; d0 < ND; ++d0) { const u32x4 raw = *(const u32x4*)(qp + 16 * d0); qf[d0] = __builtin_bit_cast(bf16x8, raw); }
    } else {
        const bf16_t* qp = P.Q + row * 768 + h * 96 + hi * 8; const float* qs = P.QSS + row * 24 + h * 3;
        const float rstd = rsqf((qs[0] + qs[1] + qs[2]) * (1.f / 96.f) + EPS);
        f32x4 fa[ND], fb[ND];
#pragma unroll
        for (int d0 = 0; d0 < ND; ++d0) { const u32x4 raw = *(const u32x4*)(qp + 16 * d0);
            fa[d0] = unpk4(raw.x, raw.y) * rstd * *(const f32x4*)(P.gq + 16 * d0 + 8 * hi); fb[d0] = unpk4(raw.z, raw.w) * rstd * *(const f32x4*)(P.gq + 16 * d0 + 8 * hi + 4); }
        { const int ti = qtok * 16 + 8 * hi;
          const f32x4 ca = *(const f32x4*)(P.cosT + ti), cb = *(const f32x4*)(P.cosT + ti + 4), sa = *(const f32x4*)(P.sinT + ti), sb = *(const f32x4*)(P.sinT + ti + 4);
          const f32x4 x1a = fa[4 % ND], x1b = fb[4 % ND], x2a = fa[5 % ND], x2b = fb[5 % ND];
          fa[4 % ND] = x1a * ca - x2a * sa; fb[4 % ND] = x1b * cb - x2b * sb; fa[5 % ND] = x1a * sa + x2a * ca; fb[5 % ND] = x1b * sb + x2b * cb; }
#pragma unroll
        for (int d0 = 0; d0 < ND; ++d0) { fa[d0] *= QSC_MLA; fb[d0] *= QSC_MLA; qf[d0] = __builtin_bit_cast(bf16x8, pack8(fa[d0], fb[d0])); }
    }
}
typedef int v8i __attribute__((ext_vector_type(8)));
typedef int i32x4 __attribute__((ext_vector_type(4)));
__device__ __forceinline__ void att_load_q8(const AttnP& P, size_t row, int qtok, int h, int hi, v8i (&q8)[2]) {
    const bf16_t* qp = P.Q + row * 768 + h * 96; const float* qs = P.QSS + row * 24 + h * 3;
    const float rstd = rsqf((qs[0] + qs[1] + qs[2]) * (1.f / 96.f) + EPS) * (QSC_MLA * 16.f);
    f32x4 f0[8], f1[8];
#pragma unroll
    for (int c = 0; c < 4; ++c) { const u32x4 raw = *(const u32x4*)(qp + 32 * hi + 8 * c);
        f0[2 * c] = unpk4(raw.x, raw.y) * rstd * *(const f32x4*)(P.gq + 32 * hi + 8 * c); f0[2 * c + 1] = unpk4(raw.z, raw.w) * rstd * *(const f32x4*)(P.gq + 32 * hi + 8 * c + 4); }
#pragma unroll
    for (int c = 0; c < 8; ++c) f1[c] = (f32x4){0.f, 0.f, 0.f, 0.f};
    if (hi == 0) {
#pragma unroll
        for (int c = 0; c < 4; ++c) { const u32x4 raw = *(const u32x4*)(qp + 64 + 8 * c);
            f1[2 * c] = unpk4(raw.x, raw.y) * rstd * *(const f32x4*)(P.gq + 64 + 8 * c); f1[2 * c + 1] = unpk4(raw.z, raw.w) * rstd * *(const f32x4*)(P.gq + 64 + 8 * c + 4); }
#pragma unroll
        for (int i = 0; i < 4; ++i) { const f32x4 cc = *(const f32x4*)(P.cosT + qtok * 16 + 4 * i), ss = *(const f32x4*)(P.sinT + qtok * 16 + 4 * i);
            const f32x4 x1 = f1[i], x2 = f1[4 + i]; f1[i] = x1 * cc - x2 * ss; f1[4 + i] = x1 * ss + x2 * cc; }
    }
#pragma unroll
    for (int v = 0; v < 8; ++v) { q8[0][v] = (int)pk4_fp8(f0[v][0], f0[v][1], f0[v][2], f0[v][3]); q8[1][v] = (int)pk4_fp8(f1[v][0], f1[v][1], f1[v][2], f1[v][3]); }
}
typedef short s16x4 __attribute__((ext_vector_type(4)));
__device__ __forceinline__ s16x4 att_vtr(LAS const unsigned char* p) { return __builtin_bit_cast(s16x4, __builtin_amdgcn_ds_read_tr16_b64_v4i16((LAS s16x4*)p)); }
__device__ __forceinline__ bf16x8 att_pack(const f32x16& p, int b8) {
    u32x4 pw; pw.x = cvt_pk_bf16(p[b8 + 0], p[b8 + 1]); pw.y = cvt_pk_bf16(p[b8 + 2], p[b8 + 3]); pw.z = cvt_pk_bf16(p[b8 + 4], p[b8 + 5]); pw.w = cvt_pk_bf16(p[b8 + 6], p[b8 + 7]);
    return __builtin_bit_cast(bf16x8, pw);
}
__device__ __forceinline__ void att_store_o(const AttnP& P, size_t row, int h, int hi, const f32x16& o0, const f32x16& o1, float lsum) {
    lsum += __shfl_xor(lsum, 32);
    const float inv = 1.f / lsum;
    const bf16_t* gp = P.G + row * 512 + h * 64 + 4 * hi; bf16_t* op = P.O + row * 512 + h * 64 + 4 * hi;
#pragma unroll
    for (int a = 0; a < 4; ++a) {
        { const u32x2 g = *(const u32x2*)(gp + 8 * a); const f32x4 gg = unpk4(g.x, g.y);
          u32x2 o; o.x = cvt_pk_bf16(o0[4 * a] * inv * gg[0], o0[4 * a + 1] * inv * gg[1]); o.y = cvt_pk_bf16(o0[4 * a + 2] * inv * gg[2], o0[4 * a + 3] * inv * gg[3]); *(u32x2*)(op + 8 * a) = o; }
        { const u32x2 g = *(const u32x2*)(gp + 32 + 8 * a); const f32x4 gg = unpk4(g.x, g.y);
          u32x2 o; o.x = cvt_pk_bf16(o1[4 * a] * inv * gg[0], o1[4 * a + 1] * inv * gg[1]); o.y = cvt_pk_bf16(o1[4 * a + 2] * inv * gg[2], o1[4 * a + 3] * inv * gg[3]); *(u32x2*)(op + 32 + 8 * a) = o; }
    }
}

template <int DK, bool ISNA, bool F8>
__device__ __forceinline__ void attn_phase64(LAS unsigned char* lds, const AttnP& P, int G, int bid) {
    constexpr int DKG = F8 ? 64 : DK;
    constexpr int KP = DKG * 2 + 16, VP = 192  , KBYTES = 64 * KP, STG = KBYTES + 64 * VP, ND = DK / 16, KCH = DKG / 8, TBL = 2 * STG;
    int tid = threadIdx.x; asm volatile("" : "+v"(tid));
    const int lane = tid & 63, w = __builtin_amdgcn_readfirstlane(tid >> 6), r32 = lane & 31, hi = lane >> 5;
    const int vcu = (G & 7) == 0 ? (bid & 7) * (G >> 3) + (bid >> 3) : bid;
        const int ka8 = r32 * KP + hi * 32; const int ka = r32 * KP + hi * 16;
    const int va = KBYTES + (4 * hi + ((lane & 15) >> 2)) * VP + (16 * ((lane >> 4) & 1) + 4 * (lane & 3)) * 2;
    LAS float* tbl = (LAS float*)(lds + TBL + 256);
    constexpr int KC = KCH + 1, NKI = KC, NVI = 12, NI = NKI + NVI;
    int soff[3];
#pragma unroll
    for (int i = 0; i < 3; ++i) { const int j = w + 8 * i;
        if (j < NKI) { const int c = 64 * j + lane, r = c / KC, col = min(c % KC, KCH - 1); soff[i] = r * DKG + col * 8; }
        else { const int c = 64 * (j - NKI) + lane, kr = c / 12, col = min(c % 12, 7); soff[i] = kr * 64 + col * 8; } }
#define ATT_DMA(t, so) do { _Pragma("unroll") for (int i_ = 0; i_ < 3; ++i_) { const int j_ = w + 8 * i_; \
        if (j_ < NKI) __builtin_amdgcn_global_load_lds((const unsigned*)(Kb + (size_t)(t) * 64 * DKG + soff[i_]), (LAS unsigned*)(lds + (so) + j_ * 1024), 16, 0, 0); \
        else if (j_ < NI) __builtin_amdgcn_global_load_lds((const unsigned*)(Vb + (size_t)(t) * 64 * 64 + soff[i_]), (LAS unsigned*)(lds + (so) + KBYTES + (j_ - NKI) * 1024), 16, 0, 0); } } while (0)
#define ATT_SYNC() do { asm volatile("s_waitcnt vmcnt(0)" ::: "memory"); __syncthreads(); } while (0)
    if (w >= 4) __builtin_amdgcn_s_setprio(1);
    for (int u = vcu; u < 1024; u += G) {
        const int bh = u >> 3, qb = u & 7, b = bh >> 3, h = bh & 7;
        const int qtok = qb * 512 + w * 64 + r32; const size_t row = (size_t)b * 4096 + qtok;
        int t_lo = 0, t_hi = 64, my_lo = 0, my_hi = 64, rq = 0;
        if (ISNA) { rq = 8 * qb + w; my_lo = min(max(rq - 4, 0), 56); my_hi = my_lo + 8; t_lo = min(max(8 * qb - 4, 0), 56); t_hi = min(max(8 * qb + 3, 0), 56) + 8; }
        const bf16_t* Kb = P.K + (size_t)bh * 4096 * DKG; const bf16_t* Vb = P.VT + (size_t)bh * 64 * 4096;
        __syncthreads();
        if (ISNA) { for (int i = tid; i < 15 * 32; i += 512) { const int dr = i >> 5, dc = i & 31; tbl[i] = dc < 31 ? P.bias[(h * 15 + dr) * 31 + dc] * LOG2E : 0.f; } }
        ATT_DMA(t_lo, 0);
        bf16x8 qfa[ND], qfb[ND]; v8i qa8[2], qb8[2];
        if (F8) { att_load_q8(P, row, qtok, h, hi, qa8); att_load_q8(P, row + 32, qtok + 32, h, hi, qb8); }
        else { att_load_q<DK, ISNA>(P, row, qtok, h, hi, qfa); att_load_q<DK, ISNA>(P, row + 32, qtok + 32, h, hi, qfb); }
        ATT_SYNC();
        f32x16 oa0, oa1, ob0, ob1;
#pragma unroll
        for (int r = 0; r < 16; ++r) { oa0[r] = 0.f; oa1[r] = 0.f; ob0[r] = 0.f; ob1[r] = 0.f; }
        float lsa = 0.f, lsb = 0.f;
        const int cqa = r32, csa = min(max(cqa - 8, 0), 48), cqb = 32 + r32, csb = min(max(cqb - 8, 0), 48);
        const int coffa = (4 * hi - cqa + 15) * 4, coffb = (4 * hi - cqb + 15) * 4;
        int dvala = 0, dvalb = 0;
        if (ISNA) {
#pragma unroll
            for (int k = 0; k < 32; ++k) { const int jc = (k & 3) + 8 * ((k & 15) >> 2) + 32 * (k >> 4);
                dvala |= ((unsigned)(jc + 4 * hi - csa) < 16u ? 1 : 0) << k; dvalb |= ((unsigned)(jc + 4 * hi - csb) < 16u ? 1 : 0) << k; }
        }
        int cur = 0;
        for (int t = t_lo; t < t_hi; ++t) {
            const bool more = (t + 1 < t_hi);
            if (more) ATT_DMA(t + 1, (cur ^ 1) * STG);
            if (!ISNA || (t >= my_lo && t < my_hi)) {
                LAS const unsigned char* st = lds + cur * STG;
                f32x16 pa0, pa1, pb0, pb1;
                const f32x16 zz = {0.f, 0.f, 0.f, 0.f, 0.f, 0.f, 0.f, 0.f, 0.f, 0.f, 0.f, 0.f, 0.f, 0.f, 0.f, 0.f};
                if (F8) {
#pragma unroll
                    for (int ks = 0; ks < 2; ++ks) {
                        const i32x4 k0l = *(LAS const i32x4*)(st + ka8 + 64 * ks), k0h = *(LAS const i32x4*)(st + ka8 + 64 * ks + 16);
                        const i32x4 k1l = *(LAS const i32x4*)(st + ka8 + 32 * KP + 64 * ks), k1h = *(LAS const i32x4*)(st + ka8 + 32 * KP + 64 * ks + 16);
                        const v8i k0 = {k0l.x, k0l.y, k0l.z, k0l.w, k0h.x, k0h.y, k0h.z, k0h.w}, k1 = {k1l.x, k1l.y, k1l.z, k1l.w, k1h.x, k1h.y, k1h.z, k1h.w};
                        pa0 = __builtin_amdgcn_mfma_scale_f32_32x32x64_f8f6f4(k0, qa8[ks], ks == 0 ? zz : pa0, 0, 0, 0, 0x7D7D7D7D, 0, 0x7D7D7D7D);
                        pa1 = __builtin_amdgcn_mfma_scale_f32_32x32x64_f8f6f4(k1, qa8[ks], ks == 0 ? zz : pa1, 0, 0, 0, 0x7D7D7D7D, 0, 0x7D7D7D7D);
                        pb0 = __builtin_amdgcn_mfma_scale_f32_32x32x64_f8f6f4(k0, qb8[ks], ks == 0 ? zz : pb0, 0, 0, 0, 0x7D7D7D7D, 0, 0x7D7D7D7D);
                        pb1 = __builtin_amdgcn_mfma_scale_f32_32x32x64_f8f6f4(k1, qb8[ks], ks == 0 ? zz : pb1, 0, 0, 0, 0x7D7D7D7D, 0, 0x7D7D7D7D);
                    }
                } else {
                { const bf16x8 k0 = *(LAS const bf16x8*)(st + ka), k1 = *(LAS const bf16x8*)(st + ka + 32 * KP);
                  pa0 = __builtin_amdgcn_mfma_f32_32x32x16_bf16(k0, qfa[0], zz, 0, 0, 0); pa1 = __builtin_amdgcn_mfma_f32_32x32x16_bf16(k1, qfa[0], zz, 0, 0, 0);
                  pb0 = __builtin_amdgcn_mfma_f32_32x32x16_bf16(k0, qfb[0], zz, 0, 0, 0); pb1 = __builtin_amdgcn_mfma_f32_32x32x16_bf16(k1, qfb[0], zz, 0, 0, 0); }
#pragma unroll
                for (int d0 = 1; d0 < ND; ++d0) {
                    const bf16x8 k0 = *(LAS const bf16x8*)(st + ka + d0 * 32), k1 = *(LAS const bf16x8*)(st + ka + 32 * KP + d0 * 32);
                    pa0 = __builtin_amdgcn_mfma_f32_32x32x16_bf16(k0, qfa[d0], pa0, 0, 0, 0); pa1 = __builtin_amdgcn_mfma_f32_32x32x16_bf16(k1, qfa[d0], pa1, 0, 0, 0);
                    pb0 = __builtin_amdgcn_mfma_f32_32x32x16_bf16(k0, qfb[d0], pb0, 0, 0, 0); pb1 = __builtin_amdgcn_mfma_f32_32x32x16_bf16(k1, qfb[d0], pb1, 0, 0, 0);
                }
                }
                LAS const unsigned char* trow = (LAS const unsigned char*)tbl + (t - rq + 7) * 128;
                att_softmax<ISNA, 0>(pa0, pa1, lsa, trow + coffa, dvala);
                att_softmax<ISNA, 1>(pb0, pb1, lsb, trow + coffb, dvalb);
#pragma unroll
                for (int ks = 0; ks < 4; ++ks) {
                    const s16x4 a0l = att_vtr(st + va + ks * 16 * VP), a0h = att_vtr(st + va + ks * 16 * VP + 8 * VP), a1l = att_vtr(st + va + ks * 16 * VP + 64), a1h = att_vtr(st + va + ks * 16 * VP + 8 * VP + 64);
                    const bf16x8 v0 = {a0l[0], a0l[1], a0l[2], a0l[3], a0h[0], a0h[1], a0h[2], a0h[3]}, v1 = {a1l[0], a1l[1], a1l[2], a1l[3], a1h[0], a1h[1], a1h[2], a1h[3]};
                    const bf16x8 xa = att_pack(ks < 2 ? pa0 : pa1, 8 * (ks & 1)), xb = att_pack(ks < 2 ? pb0 : pb1, 8 * (ks & 1));
                    if (!(ISNA && ks == 3)) { oa0 = __builtin_amdgcn_mfma_f32_32x32x16_bf16(v0, xa, oa0, 0, 0, 0); oa1 = __builtin_amdgcn_mfma_f32_32x32x16_bf16(v1, xa, oa1, 0, 0, 0); }
                    if (!(ISNA && ks == 0)) { ob0 = __builtin_amdgcn_mfma_f32_32x32x16_bf16(v0, xb, ob0, 0, 0, 0); ob1 = __builtin_amdgcn_mfma_f32_32x32x16_bf16(v1, xb, ob1, 0, 0, 0); }
                }
            }
            ATT_SYNC();
            cur ^= 1;
        }
        att_store_o(P, row, h, hi, oa0, oa1, lsa); att_store_o(P, row + 32, h, hi, ob0, ob1, lsb);
    }
    __builtin_amdgcn_s_setprio(0);
    __syncthreads();
#undef ATT_DMA
#undef ATT_SYNC
}

template <int MODE  >
__device__ __forceinline__ void prep_item(const float* W, int Ksrc, int Kpad, int Nsrc, const float* gain, bf16_t* dst, int kb, int grp, LAS float* scr, int lane) {
    const int p0 = grp * 32, within = p0 & 255, L0 = (p0 & ~255) + 64 * ((within >> 5) & 3) + 32 * (within >> 7), k0 = kb * 64;
    int src0 = L0; bool valid = true;
    if (MODE == 1) { if (L0 >= 2464) { if (L0 < 2560) valid = false; else src0 = L0 - 96; } }
    if (k0 >= Ksrc) valid = false;
#pragma unroll
    for (int i = 0; i < 8; ++i) { const int kk = 8 * i + (lane >> 3), n4 = (lane & 7) * 4;
        f32x4 v = {0.f, 0.f, 0.f, 0.f};
        if (valid) { v = *(const f32x4*)(W + (size_t)(k0 + kk) * Nsrc + src0 + n4); if (gain) v = v * gain[k0 + kk]; }
        LAS float* d = scr + kk * 33 + n4; d[0] = v[0]; d[1] = v[1]; d[2] = v[2]; d[3] = v[3]; }
    asm volatile("s_waitcnt lgkmcnt(0)" ::: "memory");
    const int c = lane & 7;
#pragma unroll
    for (int j = 0; j < 4; ++j) { const int n = (lane >> 3) + 8 * j; const LAS float* sp = scr + (8 * c) * 33 + n;
        u32x4 o; o.x = cvt_pk_bf16(sp[0], sp[33]); o.y = cvt_pk_bf16(sp[66], sp[99]); o.z = cvt_pk_bf16(sp[132], sp[165]); o.w = cvt_pk_bf16(sp[198], sp[231]);
        *(u32x4*)(dst + (size_t)(p0 + n) * Kpad + k0 + 8 * c) = o; }
    asm volatile("s_waitcnt lgkmcnt(0)" ::: "memory");
}
template <int MODE>
__device__ __forceinline__ void prep_w(const float* W, int Ksrc, int Kpad, int Nsrc, int Npad, const float* gain, bf16_t* dst, LAS float* scr, int lane, int gw, int ngw) {
    const int ngrp = Npad >> 5, total = ngrp * (Kpad >> 6);
    for (int it = gw; it < total; it += ngw) prep_item<MODE>(W, Ksrc, Kpad, Nsrc, gain, dst, it / ngrp, it % ngrp, scr, lane);
}
__device__ __forceinline__ void sincos_d(double a, float& c, float& s) {
    const double q = __builtin_rint(a * 0.63661977236758134308);
    const double r = (a - q * 1.57079632679489655800) - q * 6.12323399573676603587e-17, r2 = r * r;
    double sp = -7.6471637318198164759e-13; sp = sp * r2 + 1.6059043836821614599e-10; sp = sp * r2 - 2.5052108385441718775e-08; sp = sp * r2 + 2.7557319223985890653e-06;
    sp = sp * r2 - 1.9841269841269841270e-04; sp = sp * r2 + 8.3333333333333333333e-03; sp = sp * r2 - 1.6666666666666666667e-01; const double sn = r + r * r2 * sp;
    double cp = 4.7794773323873852974e-14; cp = cp * r2 - 1.1470745597729724714e-11; cp = cp * r2 + 2.0876756987868098979e-09; cp = cp * r2 - 2.7557319223985890653e-07;
    cp = cp * r2 + 2.4801587301587301587e-05; cp = cp * r2 - 1.3888888888888888889e-03; cp = cp * r2 + 4.1666666666666666667e-02; cp = cp * r2 - 0.5; const double cn = 1.0 + r2 * cp;
    const int qi = (int)q & 3;
    const double cc = (qi == 0) ? cn : (qi == 1) ? -sn : (qi == 2) ? -cn : sn;
    const double ss = (qi == 0) ? sn : (qi == 1) ? cn : (qi == 2) ? -sn : -cn;
    c = (float)cc; s = (float)ss;
}

#define XB_TMO      128
#define XB_XCNT(j)  (256  + 64 * (j))
#define XB_XSUB(j)  (1280 + 64 * (j))
#define XB_XGEN(j)  (2304 + 64 * (j))
#define XB_TOP      3328
#define XB_TOPGEN   3392
#define XCD_BAR_WORDS 3456
#define XB_SPIN_CAP (1u << 18)

__device__ __forceinline__ unsigned xb_ld(unsigned* p)              { return __hip_atomic_load(p, __ATOMIC_RELAXED, __HIP_MEMORY_SCOPE_AGENT); }
__device__ __forceinline__ unsigned xb_add(unsigned* p, unsigned v) { return __hip_atomic_fetch_add(p, v, __ATOMIC_RELAXED, __HIP_MEMORY_SCOPE_AGENT); }
__device__ __forceinline__ unsigned xb_xcc_id() { return (unsigned)__builtin_amdgcn_s_getreg((3 << 11) | 20) & 0xFu; }
#define XB_SPIN(cond, bar) do { unsigned _sp = 0; while (cond) { __builtin_amdgcn_s_sleep(1); \
    if ((++_sp & 255u) == 0u) { if (xb_ld(&(bar)[XB_TMO])) break; if (_sp > XB_SPIN_CAP) { atomicAdd(&(bar)[XB_TMO], 1u); break; } } } } while (0)

struct XcdBarrier {
    unsigned* bar; unsigned x;
    volatile LAS unsigned* st;
};

__device__ __forceinline__ XcdBarrier xcd_barrier_post(unsigned* bar, volatile LAS unsigned* st) {
    XcdBarrier b; b.bar = bar; b.x = xb_xcc_id(); b.st = st;
    if (threadIdx.x == 0) (void)xb_add(&bar[XB_XCNT(b.x)], 1u);
    return b;
}
__device__ __forceinline__ void xcd_barrier_complete(unsigned* bar, unsigned x, unsigned& nloc, unsigned& nx) {
    const unsigned G = gridDim.x * gridDim.y * gridDim.z;
    unsigned sum, cnt, mine, sp = 0u;
    for (;;) {
        sum = 0u; cnt = 0u; mine = 0u;
#pragma unroll
        for (unsigned j = 0; j < 16; ++j) { const unsigned c = xb_ld(&bar[XB_XCNT(j)]); sum += c; cnt += (c > 0u) ? 1u : 0u; mine = (j == x) ? c : mine; }
        if (sum == G) break;
        __builtin_amdgcn_s_sleep(1);
        if ((++sp & 255u) == 0u) { if (xb_ld(&bar[XB_TMO])) break; if (sp > XB_SPIN_CAP) { atomicAdd(&bar[XB_TMO], 1u); break; } }
    }
    nloc = mine > 0u ? mine : 1u; nx = cnt > 0u ? cnt : 1u;
}

__device__ __forceinline__ void xcd_barrier(const XcdBarrier& b) {
    asm volatile("s_waitcnt vmcnt(0)" ::: "memory");
    __syncthreads();
    if (threadIdx.x == 0) {
        unsigned* bar = b.bar;
        __builtin_amdgcn_s_waitcnt(0);
        unsigned nloc = b.st[0], nx = b.st[1];
        if (nloc == 0u) { xcd_barrier_complete(bar, b.x, nloc, nx); b.st[0] = nloc; b.st[1] = nx; }
        const unsigned old = xb_add(&bar[XB_XSUB(b.x)], 1u);
        const unsigned gen = old / nloc;
        if (old + 1u == (gen + 1u) * nloc) {
            __builtin_amdgcn_fence(__ATOMIC_RELEASE, "agent");
            asm volatile("s_waitcnt vmcnt(0)" ::: "memory");
            const unsigned og = xb_add(&bar[XB_TOP], 1u);
            const unsigned tg = og / nx;
            if (og + 1u == (tg + 1u) * nx) xb_add(&bar[XB_TOPGEN], 1u);
            else XB_SPIN(xb_ld(&bar[XB_TOPGEN]) == tg, bar);
            __builtin_amdgcn_fence(__ATOMIC_ACQUIRE, "agent");
            xb_add(&bar[XB_XGEN(b.x)], 1u);
            asm volatile("s_waitcnt vmcnt(0)" ::: "memory");
        } else {
            XB_SPIN(xb_ld(&bar[XB_XGEN(b.x)]) == gen, bar);
            __builtin_amdgcn_fence(__ATOMIC_ACQUIRE, "agent");
            asm volatile("s_waitcnt vmcnt(0)" ::: "memory");
        }
    }
    __syncthreads();
}

struct Params { const float* in[15]; float* out; unsigned char* ws; };

#define WSB() size_t wz_ = 0; asm volatile("" : "+s"(wz_)); unsigned char* wsl = p.ws + wz_
#define WP(T, off) ((T*)(wsl + (off)))
__global__ void __launch_bounds__(512, 2) hybrid_fwd(Params p) {
    extern __shared__ __attribute__((aligned(16))) unsigned char lds_raw[];
    LAS unsigned char* lds = (LAS unsigned char*)lds_raw;
    cg::grid_group grid = cg::this_grid();
    const int tid = threadIdx.x, G = gridDim.x, bid = blockIdx.x;
    const int gtid = bid * 512 + tid, gthreads = G * 512;
    volatile LAS unsigned* xst = (volatile LAS unsigned*)(lds + 131072);
    if (tid < 16) xst[tid] = 0u;
    __syncthreads();
    const XcdBarrier xbar = xcd_barrier_post((unsigned*)(p.ws + WS_BND), xst);

    { WSB();
      const float* ln_g = p.in[1]; const float* w_in = p.in[2]; const float* cq_norm = p.in[6]; const float* ckv_norm = p.in[7]; const float* w_uq = p.in[8]; const float* w_ukv = p.in[9];
      const float* w_o_na = p.in[12]; const float* w_o_mla = p.in[13]; const float* w_out = p.in[14];
      LAS float* scr = (LAS float*)(lds + (tid >> 6) * 8704); const int gwave = bid * 8 + (tid >> 6), nwave = G * 8;
      for (int l = 0; l < NLAYER; ++l) {
        prep_w<1>(w_in + (size_t)l * 1024 * DIN, 1024, 1024, DIN, NIN, ln_g + l * 1024, WP(bf16_t, WS_WIN) + (size_t)l * NIN * 1024, scr, tid & 63, gwave, nwave);
        prep_w<0>(w_uq + (size_t)l * 256 * 768, 256, 256, 768, 768, cq_norm + l * 256, WP(bf16_t, WS_WUQ) + (size_t)l * 768 * 256, scr, tid & 63, gwave, nwave);
        prep_w<0>(w_ukv + (size_t)l * 128 * 1024, 128, 256, 1024, 1024, ckv_norm + l * 128, WP(bf16_t, WS_WUKV) + (size_t)l * 1024 * 256, scr, tid & 63, gwave, nwave);
        prep_w<0>(w_o_na + (size_t)l * 512 * 1024, 512, 512, 1024, 1024, nullptr, WP(bf16_t, WS_WONA) + (size_t)l * 1024 * 512, scr, tid & 63, gwave, nwave);
        prep_w<0>(w_o_mla + (size_t)l * 512 * 1024, 512, 512, 1024, 1024, nullptr, WP(bf16_t, WS_WOMLA) + (size_t)l * 1024 * 512, scr, tid & 63, gwave, nwave);
        prep_w<0>(w_out + (size_t)l * 1024 * 1024, 1024, 1024, 1024, 1024, nullptr, WP(bf16_t, WS_WOUT) + (size_t)l * 1024 * 1024, scr, tid & 63, gwave, nwave);
      }
      float* COS = WP(float, WS_COS); float* SIN = WP(float, WS_SIN);
      for (int idx = gtid; idx < SEQ * 16; idx += gthreads) {
        const int pos = idx >> 4, i = idx & 15, k = i & 7; const int coord = (i < 8) ? (pos >> 6) : (pos & 63);
        double inv = (k & 1) ? 0.31622776601683794 : 1.0; const int e = k >> 1; inv *= (e == 0) ? 1.0 : (e == 1) ? 0.1 : (e == 2) ? 0.01 : 0.001;
        float c, s; sincos_d((double)coord * inv, c, s); COS[idx] = c; SIN[idx] = s;
      }
      { const int lane = tid & 63, wave = tid >> 6; const int gw = bid * 8 + wave, NGW = G * 8;
        const float* x_in = p.in[0]; bf16_t* XB = WP(bf16_t, WS_XB); float* RSX = WP(float, WS_RSX);
        for (int m0 = gw; m0 < MTOK; m0 += 4 * NGW) {
          f32x4 v[4][4];
#pragma unroll
          for (int r = 0; r < 4; ++r) { const f32x4* xr = (const f32x4*)(x_in + (size_t)min(m0 + r * NGW, MTOK - 1) * 1024) + lane;
#pragma unroll
            for (int j = 0; j < 4; ++j) v[r][j] = xr[64 * j]; }
#pragma unroll
          for (int r = 0; r < 4; ++r) { const int m = m0 + r * NGW; float ss = 0.f; if (m >= MTOK) break;
#pragma unroll
            for (int j = 0; j < 4; ++j) { ss += dot4(v[r][j]); u32x2 o; o.x = cvt_pk_bf16(v[r][j][0], v[r][j][1]); o.y = cvt_pk_bf16(v[r][j][2], v[r][j][3]);
                *(u32x2*)(XB + (size_t)m * 1024 + (64 * j + lane) * 4) = o; }
#pragma unroll
            for (int o = 1; o < 64; o <<= 1) ss += __shfl_xor(ss, o);
            if (lane == 0) RSX[m] = ss; } } }
    }
    grid.sync();

    for (int l = 0; l < NLAYER; ++l) {
        { WSB(); pg8::Gemm g{WP(bf16_t, WS_XB), WP(bf16_t, WS_WIN) + (size_t)l * NIN * 1024, MTOK, NIN, opq(1024)}; pg8::StaticOrder S; S.init(MTOK, NIN, G, bid);
          EpiInProj E{WP(float, WS_RSX), p.in[3] + l * 64, p.in[4] + l * 64, p.in[11] + l * 96, WP(float, WS_COS), WP(float, WS_SIN), WP(bf16_t, WS_QNA), WP(bf16_t, WS_KNA), WP(bf16_t, WS_VTNA), WP(bf16_t, WS_GA),
                      WP(bf16_t, WS_CQ), WP(bf16_t, WS_CKV), WP(bf16_t, WS_GM), WP(bf16_t, WS_SGA), WP(bf16_t, WS_SGM), WP(float, WS_SSQ), WP(float, WS_SSKV), WP(float, WS_KPESS), WP(float, WS_RPE)};
          pg8::gemm_phase<EpiInProj, pg8::StaticOrder, true, true>(lds, g, S, E);
          }
        xcd_barrier(xbar);
        { WSB(); float* RSX = WP(float, WS_RSX); for (int i = gtid; i < MTOK; i += gthreads) RSX[i] = 0.f; }
        { WSB(); pg8::Gemm g{WP(bf16_t, WS_CQ), WP(bf16_t, WS_WUQ) + (size_t)l * 768 * 256, 2 * MTOK, 8192, opq(256)};
          UqKvOrder S; S.uq.init(MTOK, 768, G, bid); S.kv.init(MTOK, 1024, G, bid); S.nuq = ((MTOK / 256) * 3 + G - 1 - bid) / G; S.kvtile = 16 + l;
          EpiUqKv E{EpiUQ{WP(float, WS_SSQ), WP(bf16_t, WS_XB), WP(float, WS_QSS)}, EpiKV{WP(float, WS_SSKV), WP(float, WS_KPESS), WP(float, WS_RPE), p.in[11] + l * 96, WP(bf16_t, WS_KMLA), WP(bf16_t, WS_VTMLA)}, 16 + l};
          pg8::gemm_phase<EpiUqKv, UqKvOrder, true, true>(lds, g, S, E); }
        { WSB(); AttnP A{WP(bf16_t, WS_QNA), WP(bf16_t, WS_KNA), WP(bf16_t, WS_VTNA), WP(bf16_t, WS_GA), WP(bf16_t, WS_QNA), nullptr, nullptr, nullptr, nullptr, p.in[5] + (size_t)l * 8 * 465};
          attn_phase64<64, true, false>(lds, A, G, bid); }
        xcd_barrier(xbar);
        { WSB(); AttnP A{WP(bf16_t, WS_XB), WP(bf16_t, WS_KMLA), WP(bf16_t, WS_VTMLA), WP(bf16_t, WS_GM), WP(bf16_t, WS_OMLA), WP(float, WS_QSS), p.in[10] + l * 96, WP(float, WS_COS), WP(float, WS_SIN), nullptr};
          attn_phase64<96, false, true>(lds, A, G, bid);
          }
        xcd_barrier(xbar);
        { WSB(); pg8::Gemm g{WP(bf16_t, WS_QNA), WP(bf16_t, WS_WONA) + (size_t)l * 1024 * 512, 2 * MTOK, 4096 + 1024, opq(512)}; PairOrder S; S.base.init(MTOK, 1024, G, bid);
          EpiYP E{WP(bf16_t, WS_SGA), WP(bf16_t, WS_SGM), WP(bf16_t, WS_Y)}; pg8::gemm_phase<EpiYP, PairOrder, true, true>(lds, g, S, E); }
        xcd_barrier(xbar);
        { WSB(); pg8::Gemm g{WP(bf16_t, WS_Y), WP(bf16_t, WS_WOUT) + (size_t)l * 1024 * 1024, MTOK, 1024, opq(1024)}; pg8::StaticOrder S; S.init(MTOK, 1024, G, bid);
          EpiOut E{l == 0 ? p.in[0] : p.out, p.out, WP(bf16_t, WS_XB), WP(float, WS_RSX), l == NLAYER - 1 ? 1 : 0}; pg8::gemm_phase<EpiOut, pg8::StaticOrder, true, true>(lds, g, S, E); }
        if (l + 1 < NLAYER) xcd_barrier(xbar);
    }
}

extern "C" void kernel_launch(void* const* d_in, const int* in_sizes, int n_in, void* d_out, int out_size, void* d_ws, size_t ws_size, hipStream_t stream) {
    static int grid = 0;
    if (grid == 0) {
        if (n_in != 15 || in_sizes[0] != MTOK * 1024 || out_size != MTOK * 1024 || ws_size < WS_END) {
            fprintf(stderr, "kernel_launch: unexpected shapes (n_in %d, in0 %d, out %d, ws %zu, need %zu); nothing launched\n", n_in, n_in > 0 ? in_sizes[0] : -1, out_size, ws_size, (size_t)WS_END); grid = -1; return; }
        int dev = 0, cus = 0, per_cu = 0;
        (void)hipGetDevice(&dev); (void)hipDeviceGetAttribute(&cus, hipDeviceAttributeMultiprocessorCount, dev);
        if (hipFuncSetAttribute((const void*)hybrid_fwd, hipFuncAttributeMaxDynamicSharedMemorySize, LDS_BYTES) != hipSuccess) fprintf(stderr, "kernel_launch: hipFuncSetAttribute failed\n");
        if (hipOccupancyMaxActiveBlocksPerMultiprocessor(&per_cu, (const void*)hybrid_fwd, 512, LDS_BYTES) != hipSuccess || per_cu < 1) { fprintf(stderr, "kernel_launch: occupancy query gave %d; using 1\n", per_cu); per_cu = 1; }
        (void)hipGetLastError();
        if (cus <= 0) cus = 256;
        if (per_cu > 1) per_cu = 1;
        grid = cus * per_cu;
    }
    if (grid < 0) return;
    if (hipMemsetAsync((char*)d_ws + WS_BND, 0, XCD_BAR_WORDS * 4, stream) != hipSuccess) { fprintf(stderr, "kernel_launch: memset of barrier words failed\n"); return; }
    Params p{};
    for (int i = 0; i < 15; ++i) p.in[i] = (const float*)d_in[i];
    p.out = (float*)d_out; p.ws = (unsigned char*)d_ws;
    void* args[] = {&p};
    hipError_t e = hipLaunchCooperativeKernel((const void*)hybrid_fwd, dim3(grid), dim3(512), args, LDS_BYTES, stream);
    if (e != hipSuccess) fprintf(stderr, "kernel_launch: cooperative launch failed: %s (grid %d)\n", hipGetErrorString(e), grid);
}
```

```cpp
#include <hip/hip_runtime.h>
#include <hip/hip_cooperative_groups.h>
#include <cstdio>
#include <cstdint>
namespace cg = cooperative_groups;
namespace pg8 {
#define PG8_LAS __attribute__((address_space(3)))
typedef unsigned short bf16_t;
typedef short bf16x8 __attribute__((ext_vector_type(8)));
typedef float f32x4 __attribute__((ext_vector_type(4)));
typedef unsigned u32x4 __attribute__((ext_vector_type(4)));
constexpr int BM = 256, BK = 64, HALF = 128, HTB = HALF * BK * 2  , STAGE_BYTES = 8 * HTB, NXCD = 8, WGM = 8;

__host__ __device__ __forceinline__ int lds_byte(int r, int c) { const int st = (r >> 4) * 2 + (c >> 5), rr = r & 15, cc = c & 31, ob = rr * 64 + cc * 2; return st * 1024 + (ob ^ (((ob >> 9) & 1) << 5)); }
__host__ __device__ __forceinline__ void stage_rc(int b, int& R, int& C) { const int st = b / 1024, sb = b % 1024, swz = sb ^ (((sb >> 9) & 1) << 5); R = (st >> 1) * 16 + swz / 64; C = (st & 1) * 32 + (swz % 64) / 2; }
__host__ __device__ __forceinline__ int perm32(int rho) { const int n = rho >> 4, i = rho & 15; return 8 * (i >> 2) + 4 * n + (i & 3); }

struct Unit { int pm, pn; };
struct Gemm { const bf16_t* A; const bf16_t* Bt; int M, N, K; };

struct StaticOrder {
    int nM, nN, nwg, G, c;
    __host__ __device__ void init(int M, int N, int G_, int c_) { nM = M / BM; nN = N / BM; nwg = nM * nN; G = G_; c = c_; }
    __host__ __device__ bool next(int i, Unit& u) const {
        const long L = (long)i * G + c; if (L >= nwg) return false;
        int wgid = (int)L; { const int q = nwg / NXCD, r = nwg % NXCD, xcd = wgid % NXCD, off = wgid / NXCD; wgid = (xcd < r ? xcd * (q + 1) : r * (q + 1) + (xcd - r) * q) + off; }
        const int nig = WGM * nN, gid = wgid / nig, fm = gid * WGM, gsz = (nM - fm) < WGM ? (nM - fm) : WGM;
        u.pm = fm + ((wgid % nig) % gsz); u.pn = (wgid % nig) / gsz; return true;
    }
    __device__ __forceinline__ void a_ready(const Unit&) const {}
    __device__ __forceinline__ void done(const Unit&) const {}
};
__device__ __forceinline__ unsigned cvt_pk_bf16(float lo, float hi) { unsigned r; asm volatile("v_cvt_pk_bf16_f32 %0, %1, %2" : "=v"(r) : "v"(lo), "v"(hi)); return r; }
typedef float f32x2 __attribute__((ext_vector_type(2)));
template <class Epi, class Sched, bool ALIGN_EPI = false, bool SP2 = false>
__device__ __forceinline__ void gemm_phase(PG8_LAS unsigned char* lds, const Gemm g, const Sched& S, const Epi& E) {
    int tid = threadIdx.x; asm volatile("" : "+v"(tid));
    const int wid = __builtin_amdgcn_readfirstlane(tid >> 6), lane = tid & 63, wr = wid >> 2, wc = wid & 3, fr = lane & 15, fq = lane >> 4;
    const int K = g.K, nt = K / BK;
    unsigned voffA[2], voffB[2];
#pragma unroll
    for (int i = 0; i < 2; ++i) { int R, C; stage_rc(tid * 16 + i * 8192, R, C); const int Rb = Epi::PERM ? ((R & ~31) + perm32(R & 31)) : R;
        voffA[i] = (unsigned)(R * K + C) * 2u; voffB[i] = (unsigned)(Rb * K + C) * 2u; }
    const size_t kstep = (size_t)(BK * 2);
    const size_t hstep = (size_t)HALF * K * 2;
    const size_t tstep = 2 * hstep;
    const unsigned ldsw = (unsigned)wid * 1024u;
    const int aoff = lds_byte(wr * 64 + fr, fq * 8), boff = lds_byte(wc * 32 + fr, fq * 8);
#define PG8_SA(b, h) (((b) * 2 + (h)) * HTB)
#define PG8_SB(b, h) ((4 + (b) * 2 + (h)) * HTB)
#define PG8_STAGE(bufoff, gbase, voff) do { _Pragma("unroll") for (int _i = 0; _i < 2; ++_i) \
        __builtin_amdgcn_global_load_lds((const unsigned*)((const char*)(gbase) + (voff)[_i]), (PG8_LAS unsigned*)(lds + (bufoff) + ldsw + _i * 8192), 16, 0, 0); } while (0)
#define PG8_LDA(dst, b, h) do { _Pragma("unroll") for (int m = 0; m < 4; ++m) _Pragma("unroll") for (int k = 0; k < 2; ++k) dst[m][k] = *(const PG8_LAS bf16x8*)(lds + PG8_SA(b, h) + aoff + m * 2048 + k * 1024); } while (0)
#define PG8_LDB(dst, b, h) do { _Pragma("unroll") for (int n = 0; n < 2; ++n) _Pragma("unroll") for (int k = 0; k < 2; ++k) dst[n][k] = *(const PG8_LAS bf16x8*)(lds + PG8_SB(b, h) + boff + n * 2048 + k * 1024); } while (0)
#define PG8_MMA(ai, bj, At, Bt) do { __builtin_amdgcn_s_setprio(1); _Pragma("unroll") for (int m = 0; m < 4; ++m) _Pragma("unroll") for (int n = 0; n < 2; ++n) _Pragma("unroll") for (int k = 0; k < 2; ++k) \
        acc[ai][bj][m][n] = __builtin_amdgcn_mfma_f32_16x16x32_bf16(Bt[n][k], At[m][k], acc[ai][bj][m][n], 0, 0, 0); __builtin_amdgcn_s_setprio(0); } while (0)
#define PG8_WAIT_V(n) asm volatile("s_waitcnt vmcnt(" #n ")" ::: "memory")
#define PG8_WAIT_L(n) asm volatile("s_waitcnt lgkmcnt(" #n ")" ::: "memory")
#define PG8_BAR __builtin_amdgcn_s_barrier()
#define PG8_SCHED __builtin_amdgcn_sched_barrier(0)
    Unit cur, nxt; int ui = 0;
    if (!S.next(0, cur)) return;
    f32x4 acc[2][2][4][2];
#pragma unroll
    for (int a = 0; a < 2; ++a)
#pragma unroll
        for (int b = 0; b < 2; ++b)
#pragma unroll
            for (int m = 0; m < 4; ++m)
#pragma unroll
                for (int n = 0; n < 2; ++n) acc[a][b][m][n] = (f32x4){0.f, 0.f, 0.f, 0.f};
    bf16x8 At[4][2], B0[2][2], B1[2][2];
    const char* cA = (const char*)g.A + (size_t)cur.pm * tstep; const char* cB = (const char*)g.Bt + (size_t)cur.pn * tstep;
    S.a_ready(cur);
    if constexpr (SP2) {
        PG8_STAGE(PG8_SB(0, 0), cB, voffB); PG8_STAGE(PG8_SB(0, 1), cB + hstep, voffB); PG8_STAGE(PG8_SA(0, 0), cA, voffA); PG8_STAGE(PG8_SA(0, 1), cA + hstep, voffA);
        if (wr == 1) PG8_BAR;
        PG8_WAIT_V(2); PG8_BAR;
        PG8_STAGE(PG8_SB(1, 0), cB + kstep, voffB); PG8_STAGE(PG8_SA(1, 0), cA + kstep, voffA); PG8_STAGE(PG8_SB(1, 1), cB + hstep + kstep, voffB);
        PG8_WAIT_V(6); PG8_BAR;
    } else {
        PG8_STAGE(PG8_SB(0, 0), cB, voffB); PG8_STAGE(PG8_SA(0, 0), cA, voffA); PG8_STAGE(PG8_SB(0, 1), cB + hstep, voffB); PG8_STAGE(PG8_SA(0, 1), cA + hstep, voffA);
        if (wr == 1) PG8_BAR;
        PG8_WAIT_V(4); PG8_BAR;
        PG8_STAGE(PG8_SB(1, 0), cB + kstep, voffB); PG8_STAGE(PG8_SA(1, 0), cA + kstep, voffA); PG8_STAGE(PG8_SB(1, 1), cB + hstep + kstep, voffB);
        PG8_WAIT_V(6); PG8_BAR;
    }
    for (;;) {
        const bool has_next = S.next(ui + 1, nxt);
        const char* nA = has_next ? (const char*)g.A + (size_t)nxt.pm * tstep : cA; const char* nB = has_next ? (const char*)g.Bt + (size_t)nxt.pn * tstep : cB;
        for (int t = 0; t < nt; t += 2) {
            const bool last = (t == nt - 2);
            const char* a1 = cA + (size_t)(t + 1) * kstep;
            const char* a2 = last ? nA : cA + (size_t)(t + 2) * kstep; const char* b2 = last ? nB : cB + (size_t)(t + 2) * kstep;
            const char* a3 = a2 + kstep; const char* b3 = b2 + kstep;
            if (last && has_next) S.a_ready(nxt);
            if constexpr (SP2) {
            PG8_LDB(B0, 0, 0); PG8_LDB(B1, 0, 1); PG8_SCHED; PG8_LDA(At, 0, 0); PG8_STAGE(PG8_SA(1, 1), a1 + hstep, voffA);
            PG8_WAIT_V(8); PG8_WAIT_L(0); PG8_BAR; PG8_MMA(0, 0, At, B0); PG8_MMA(0, 1, At, B1); PG8_BAR; PG8_SCHED;
            PG8_LDA(At, 0, 1); PG8_STAGE(PG8_SB(0, 0), b2, voffB); PG8_STAGE(PG8_SB(0, 1), b2 + hstep, voffB); PG8_STAGE(PG8_SA(0, 0), a2, voffA);
            PG8_WAIT_V(8); PG8_WAIT_L(0); PG8_BAR; PG8_MMA(1, 0, At, B0); PG8_MMA(1, 1, At, B1); PG8_BAR; PG8_SCHED;
            PG8_LDB(B0, 1, 0); PG8_LDB(B1, 1, 1); PG8_SCHED; PG8_LDA(At, 1, 0); PG8_STAGE(PG8_SA(0, 1), a2 + hstep, voffA);
            PG8_WAIT_V(8); PG8_WAIT_L(0); PG8_BAR; PG8_MMA(0, 0, At, B0); PG8_MMA(0, 1, At, B1); PG8_BAR; PG8_SCHED;
            PG8_LDA(At, 1, 1); PG8_STAGE(PG8_SB(1, 0), b3, voffB); PG8_STAGE(PG8_SB(1, 1), b3 + hstep, voffB); PG8_STAGE(PG8_SA(1, 0), a3, voffA);
            PG8_WAIT_V(8); PG8_WAIT_L(0); PG8_BAR; PG8_MMA(1, 0, At, B0); PG8_MMA(1, 1, At, B1); PG8_BAR; PG8_SCHED;
            } else {
            PG8_LDB(B0, 0, 0); PG8_SCHED; PG8_LDA(At, 0, 0); PG8_STAGE(PG8_SA(1, 1), a1 + hstep, voffA);
            PG8_WAIT_L(8); PG8_BAR; PG8_WAIT_L(0); PG8_MMA(0, 0, At, B0); PG8_BAR; PG8_SCHED;
            PG8_LDB(B1, 0, 1); PG8_STAGE(PG8_SB(0, 0), b2, voffB);
            PG8_BAR; PG8_WAIT_L(0); PG8_MMA(0, 1, At, B1); PG8_BAR;
            PG8_LDA(At, 0, 1); PG8_STAGE(PG8_SA(0, 0), a2, voffA);
            PG8_BAR; PG8_WAIT_L(0); PG8_MMA(1, 0, At, B0); PG8_BAR; PG8_SCHED;
            PG8_STAGE(PG8_SB(0, 1), b2 + hstep, voffB);
            PG8_WAIT_V(6); PG8_BAR; PG8_MMA(1, 1, At, B1); PG8_BAR;
            PG8_LDB(B0, 1, 0); PG8_SCHED; PG8_LDA(At, 1, 0); PG8_STAGE(PG8_SA(0, 1), a2 + hstep, voffA);
            PG8_WAIT_L(8); PG8_BAR; PG8_WAIT_L(0); PG8_MMA(0, 0, At, B0); PG8_BAR; PG8_SCHED;
            PG8_LDB(B1, 1, 1); PG8_STAGE(PG8_SB(1, 0), b3, voffB);
            PG8_BAR; PG8_WAIT_L(0); PG8_MMA(0, 1, At, B1); PG8_BAR;
            PG8_LDA(At, 1, 1); PG8_STAGE(PG8_SA(1, 0), a3, voffA);
            PG8_BAR; PG8_WAIT_L(0); PG8_MMA(1, 0, At, B0); PG8_BAR; PG8_SCHED;
            PG8_STAGE(PG8_SB(1, 1), b3 + hstep, voffB);
            PG8_WAIT_V(6); PG8_BAR; PG8_MMA(1, 1, At, B1); PG8_BAR;
            }
        }
        if constexpr (ALIGN_EPI) { if (wr == 0) PG8_BAR; }
        if constexpr (!Epi::AFTER_DRAIN) { E(acc, cur, wr, wc, fr, fq); S.done(cur); }
        if (!has_next) break;
#pragma unroll
        for (int a = 0; a < 2; ++a)
#pragma unroll
            for (int b = 0; b < 2; ++b)
#pragma unroll
                for (int m = 0; m < 4; ++m)
#pragma unroll
                    for (int n = 0; n < 2; ++n) acc[a][b][m][n] = (f32x4){0.f, 0.f, 0.f, 0.f};
        cur = nxt; cA = nA; cB = nB; ++ui;
        if constexpr (ALIGN_EPI) { if (wr == 1) PG8_BAR; }
    }
    PG8_WAIT_V(0);
    if constexpr (!ALIGN_EPI) { if (wr == 0) PG8_BAR; }
    PG8_BAR;
    if constexpr (Epi::AFTER_DRAIN) { E.fused(acc, cur, wr, wc, fr, fq, lds, wid, lane); S.done(cur); }
#undef PG8_SA
#undef PG8_SB
#undef PG8_STAGE
#undef PG8_LDA
#undef PG8_LDB
#undef PG8_MMA
#undef PG8_WAIT_V
#undef PG8_WAIT_L
#undef PG8_BAR
#undef PG8_SCHED
}
}

#define LAS __attribute__((address_space(3)))
typedef unsigned short bf16_t;
typedef short bf16x8 __attribute__((ext_vector_type(8)));
typedef float f32x4 __attribute__((ext_vector_type(4)));
typedef float f32x2 __attribute__((ext_vector_type(2)));
typedef float f32x16 __attribute__((ext_vector_type(16)));
typedef unsigned u32x4 __attribute__((ext_vector_type(4)));
typedef unsigned u32x2 __attribute__((ext_vector_type(2)));
using pg8::Unit; using pg8::cvt_pk_bf16;

constexpr int MTOK = 65536, SEQ = 4096, NLAYER = 4, NIN = 5120, DIN = 5024;
constexpr float EPS = 1e-6f, LOG2E = 1.4426950408889634f;
constexpr float QSC_NA = 0.125f * LOG2E;
constexpr float QSC_MLA = 0.10206207261596575f * LOG2E;

constexpr size_t MiB = 1u << 20;
constexpr size_t WS_WIN = 0, WS_WUQ = 40 * MiB, WS_WUKV = 42 * MiB, WS_WONA = 44 * MiB, WS_WOMLA = 48 * MiB, WS_WOUT = 52 * MiB,
    WS_COS = 60 * MiB, WS_SIN = 60 * MiB + 512 * 1024, WS_BND = 61 * MiB, WS_RSX = 62 * MiB, WS_KPESS = 62 * MiB + 256 * 1024, WS_SSKV = 62 * MiB + 512 * 1024,
    WS_SSQ = 63 * MiB, WS_RPE = 64 * MiB, WS_QSS = 72 * MiB, WS_CQ = 78 * MiB, WS_CKV = 110 * MiB, WS_XB = 142 * MiB, WS_QNA = 270 * MiB,
    WS_KNA = 334 * MiB, WS_VTNA = 398 * MiB, WS_GA = 462 * MiB, WS_OMLA = WS_KNA  , WS_GM = 526 * MiB, WS_SGA = 590 * MiB, WS_SGM = 718 * MiB,
    WS_KMLA = 846 * MiB, WS_VTMLA = 942 * MiB, WS_Y = WS_KMLA  , WS_END = 1006 * MiB;
constexpr int LDS_BYTES = 131072 + 1024;

__device__ __forceinline__ float bflo(unsigned w) { return __uint_as_float(w << 16); }
__device__ __forceinline__ float bfhi(unsigned w) { return __uint_as_float(w & 0xffff0000u); }
__device__ __forceinline__ f32x4 unpk4(unsigned a, unsigned b) { return (f32x4){bflo(a), bfhi(a), bflo(b), bfhi(b)}; }
__device__ __forceinline__ u32x4 pack8(f32x4 a, f32x4 b) { u32x4 w; w.x = cvt_pk_bf16(a[0], a[1]); w.y = cvt_pk_bf16(a[2], a[3]); w.z = cvt_pk_bf16(b[0], b[1]); w.w = cvt_pk_bf16(b[2], b[3]); return w; }
__device__ __forceinline__ unsigned pk4_fp8(float a, float b, float c, float d) { int w = 0; w = __builtin_amdgcn_cvt_pk_fp8_f32(a, b, w, false); w = __builtin_amdgcn_cvt_pk_fp8_f32(c, d, w, true); return (unsigned)w; }
__device__ __forceinline__ u32x2 pack8_fp8(f32x4 a, f32x4 b) { u32x2 w; w.x = pk4_fp8(a[0], a[1], a[2], a[3]); w.y = pk4_fp8(b[0], b[1], b[2], b[3]); return w; }
__device__ __forceinline__ float rsqf(float x) { return __builtin_amdgcn_rsqf(x); }
__device__ __forceinline__ float sig1(float x) { return __builtin_amdgcn_rcpf(1.f + __builtin_amdgcn_exp2f(-LOG2E * x)); }
__device__ __forceinline__ f32x4 sig4(f32x4 v) { return (f32x4){sig1(v[0]), sig1(v[1]), sig1(v[2]), sig1(v[3])}; }
__device__ __forceinline__ f32x4 silu4(f32x4 v) { return v * sig4(v); }
__device__ __forceinline__ float dot4(f32x4 v) { return (v[0] * v[0] + v[1] * v[1]) + (v[2] * v[2] + v[3] * v[3]); }
__device__ __forceinline__ float red4(float s) { s += __shfl_xor(s, 16); s += __shfl_xor(s, 32); return s; }
__device__ __forceinline__ int opq(int v) { asm volatile("" : "+s"(v)); return v; }
__device__ __forceinline__ int perm16(int f) { return (f & 3) | ((f & 8) >> 1) | ((f & 4) << 1); }

#define FOR_AI_M _Pragma("unroll") for (int ai = 0; ai < 2; ++ai) _Pragma("unroll") for (int m = 0; m < 4; ++m)
#define ROWFENCE asm volatile("" ::: "memory")
#define FOR_BJ _Pragma("unroll") for (int bj = 0; bj < 2; ++bj)

template <int ACT  >
__device__ __forceinline__ void store_rows(bf16_t* base, int ld, int col0, const f32x4 (&acc)[2][2][4][2], const float (&rs)[2][4], int rowb, int c8) {
    FOR_AI_M { ROWFENCE; int row = rowb + ai * 128 + m * 16; asm volatile("" : "+v"(row)); const float r0 = rs[ai][m]; bf16_t* dst = base + (size_t)row * ld + col0 + c8;
        FOR_BJ {
            if (ACT == 2) {
                const float cr = -LOG2E * r0;
                f32x4 a = acc[ai][bj][m][0] * cr, b = acc[ai][bj][m][1] * cr;
                a = (f32x4){__builtin_amdgcn_exp2f(a[0]), __builtin_amdgcn_exp2f(a[1]), __builtin_amdgcn_exp2f(a[2]), __builtin_amdgcn_exp2f(a[3])} * (1.f / 255.f) + (1.f / 255.f);
                b = (f32x4){__builtin_amdgcn_exp2f(b[0]), __builtin_amdgcn_exp2f(b[1]), __builtin_amdgcn_exp2f(b[2]), __builtin_amdgcn_exp2f(b[3])} * (1.f / 255.f) + (1.f / 255.f);
                int qx = __builtin_amdgcn_cvt_pk_u8_f32(__builtin_amdgcn_rcpf(a[0]), 0, 0); qx = __builtin_amdgcn_cvt_pk_u8_f32(__builtin_amdgcn_rcpf(a[1]), 1, qx);
                qx = __builtin_amdgcn_cvt_pk_u8_f32(__builtin_amdgcn_rcpf(a[2]), 2, qx); qx = __builtin_amdgcn_cvt_pk_u8_f32(__builtin_amdgcn_rcpf(a[3]), 3, qx);
                int qy = __builtin_amdgcn_cvt_pk_u8_f32(__builtin_amdgcn_rcpf(b[0]), 0, 0); qy = __builtin_amdgcn_cvt_pk_u8_f32(__builtin_amdgcn_rcpf(b[1]), 1, qy);
                qy = __builtin_amdgcn_cvt_pk_u8_f32(__builtin_amdgcn_rcpf(b[2]), 2, qy); qy = __builtin_amdgcn_cvt_pk_u8_f32(__builtin_amdgcn_rcpf(b[3]), 3, qy);
                u32x2 q; q.x = (unsigned)qx; q.y = (unsigned)qy;
                *(u32x2*)((unsigned char*)base + (size_t)row * ld + col0 + c8 + 32 * bj) = q;
            } else { f32x4 a = acc[ai][bj][m][0] * r0, b = acc[ai][bj][m][1] * r0;
                if (ACT == 1) { a = silu4(a); b = silu4(b); }
                *(u32x4*)(dst + 32 * bj) = pack8(a, b); } } }
}
__device__ __forceinline__ void store_vt(bf16_t* vt_head  , int sp, f32x4 v, int dv) {
    const unsigned w0 = cvt_pk_bf16(v[0], v[1]), w1 = cvt_pk_bf16(v[2], v[3]);
    bf16_t* d = vt_head + (size_t)dv * 4096 + sp;
    d[0] = (bf16_t)(w0 & 0xffffu); d[4096] = (bf16_t)(w0 >> 16); d[8192] = (bf16_t)(w1 & 0xffffu); d[12288] = (bf16_t)(w1 >> 16);
}

struct EpiInProj {
    static constexpr bool PERM = true, AFTER_DRAIN = false;
    const float* rsx; const float* gq; const float* gk; const float* gkm; const float* cosT; const float* sinT;
    bf16_t *QNA, *KNA, *VTNA, *GA, *CQ, *CKV, *GM, *SGA, *SGM; float *SSQ, *SSKV, *KPESS, *RPE;
    __device__ __forceinline__ void operator()(const f32x4 (&acc)[2][2][4][2], const Unit& u, int wr, int wc, int fr_, int fq_) const {
        int fr = fr_, fq = fq_; asm volatile("" : "+v"(fr), "+v"(fq));
        const int pn = u.pn, rowb = u.pm * 256 + wr * 64 + fr, c8 = 8 * fq;
        float rs[2][4];
        FOR_AI_M rs[ai][m] = rsqf(rsx[rowb + ai * 128 + m * 16] * (1.f / 1024.f) + EPS);
        if (pn < 4) {
            const bool isq = pn < 2; const int h = (pn & 1) * 4 + wc; const float* g = isq ? gq : gk; const float gs = isq ? QSC_NA : 1.f;
            f32x4 gv[2][2];
            FOR_BJ { gv[bj][0] = *(const f32x4*)(g + 32 * bj + c8) * gs; gv[bj][1] = *(const f32x4*)(g + 32 * bj + c8 + 4) * gs; }
            FOR_AI_M { ROWFENCE; int row = rowb + ai * 128 + m * 16; asm volatile("" : "+v"(row)); const float r0 = rs[ai][m];
                f32x4 v[2][2]; float ss = 0.f;
                FOR_BJ { v[bj][0] = acc[ai][bj][m][0] * r0; v[bj][1] = acc[ai][bj][m][1] * r0; ss += dot4(v[bj][0]) + dot4(v[bj][1]); }
                ss = red4(ss); const float rstd = rsqf(ss * (1.f / 64.f) + EPS);
                bf16_t* dst = isq ? QNA + (size_t)row * 512 + 64 * h + c8 : KNA + ((size_t)((row >> 12) * 8 + h) * 4096 + (row & 4095)) * 64 + c8;
                FOR_BJ *(u32x4*)(dst + 32 * bj) = pack8(v[bj][0] * rstd * gv[bj][0], v[bj][1] * rstd * gv[bj][1]); }
        } else if (pn < 6) {
            const int h = (pn - 4) * 4 + wc;
            FOR_AI_M { ROWFENCE; int row = rowb + ai * 128 + m * 16; asm volatile("" : "+v"(row)); const float r0 = rs[ai][m];
                bf16_t* dst = VTNA + ((size_t)((row >> 12) * 8 + h) * 4096 + (row & 4095)) * 64 + c8;
                FOR_BJ *(u32x4*)(dst + 32 * bj) = pack8(acc[ai][bj][m][0] * r0, acc[ai][bj][m][1] * r0); }
        } else if (pn < 8) { store_rows<1>(GA, 512, 64 * ((pn - 6) * 4 + wc), acc, rs, rowb, c8);
        } else if (pn == 8) {
            FOR_AI_M { ROWFENCE; int row = rowb + ai * 128 + m * 16; asm volatile("" : "+v"(row)); const float r0 = rs[ai][m]; float ss = 0.f;
                FOR_BJ { const f32x4 a = acc[ai][bj][m][0] * r0, b = acc[ai][bj][m][1] * r0; ss += dot4(a) + dot4(b);
                    *(u32x4*)(CQ + (size_t)row * 256 + 64 * wc + 32 * bj + c8) = pack8(a, b); }
                ss = red4(ss); if (fq == 0) SSQ[(size_t)row * 4 + wc] = ss; }
        } else if (pn == 9) {
            FOR_AI_M { ROWFENCE; int row = rowb + ai * 128 + m * 16; asm volatile("" : "+v"(row)); const float r0 = rs[ai][m];
                if (wc < 2) { float ss = 0.f;
                    FOR_BJ { const f32x4 a = acc[ai][bj][m][0] * r0, b = acc[ai][bj][m][1] * r0; ss += dot4(a) + dot4(b);
                        *(u32x4*)(CKV + (size_t)row * 256 + 64 * wc + 32 * bj + c8) = pack8(a, b); }
                    ss = red4(ss); if (fq == 0) SSKV[(size_t)row * 2 + wc] = ss;
                } else {
                    FOR_BJ *(u32x4*)(CKV + (size_t)row * 256 + 64 * wc + 32 * bj + c8) = (u32x4){0u, 0u, 0u, 0u};
                    if (wc == 2) {
                        const f32x4 a = acc[ai][0][m][0] * r0, b = acc[ai][0][m][1] * r0;
                        float ss = red4(dot4(a) + dot4(b)); if (fq == 0) KPESS[row] = ss;
                        const f32x4 ga = a * *(const f32x4*)(gkm + 64 + c8), gb = b * *(const f32x4*)(gkm + 64 + c8 + 4);
                        f32x4 pa, pb;
#pragma unroll
                        for (int e = 0; e < 4; ++e) { pa[e] = __shfl_xor(ga[e], 32); pb[e] = __shfl_xor(gb[e], 32); }
                        const int ti = (row & 4095) * 16 + 8 * (fq & 1);
                        const f32x4 ca = *(const f32x4*)(cosT + ti), cb = *(const f32x4*)(cosT + ti + 4), sa = *(const f32x4*)(sinT + ti), sb = *(const f32x4*)(sinT + ti + 4);
                        f32x4 oa, ob;
                        if (fq < 2) { oa = ga * ca - pa * sa; ob = gb * cb - pb * sb; }
                        else        { oa = pa * sa + ga * ca; ob = pb * sb + gb * cb; }
                        *(f32x4*)(RPE + (size_t)row * 32 + c8) = oa; *(f32x4*)(RPE + (size_t)row * 32 + c8 + 4) = ob;
                    }
                } }
        } else if (pn < 12) { store_rows<1>(GM, 512, 64 * ((pn - 10) * 4 + wc), acc, rs, rowb, c8);
        } else if (pn < 16) { store_rows<2>(SGA, 1024, 256 * (pn - 12) + 64 * wc, acc, rs, rowb, c8);
        } else { store_rows<2>(SGM, 1024, 256 * (pn - 16) + 64 * wc, acc, rs, rowb, c8); }
    }
};

struct EpiUQ {
    static constexpr bool PERM = true, AFTER_DRAIN = false;
    const float* SSQ; bf16_t* QR; float* QSS;
    __device__ __forceinline__ void operator()(const f32x4 (&acc)[2][2][4][2], const Unit& u, int wr, int wc, int fr_, int fq_) const {
        int fr = fr_, fq = fq_; asm volatile("" : "+v"(fr), "+v"(fq));
        const int pn = u.pn, rowb = u.pm * 256 + wr * 64 + fr, c8 = 8 * fq;
        f32x4 s4a[2][4];
        FOR_AI_M s4a[ai][m] = *(const f32x4*)(SSQ + (size_t)(rowb + ai * 128 + m * 16) * 4);
        FOR_AI_M { ROWFENCE; int row = rowb + ai * 128 + m * 16; asm volatile("" : "+v"(row)); const f32x4 s4 = s4a[ai][m];
            const float r0 = rsqf(((s4[0] + s4[1]) + (s4[2] + s4[3])) * (1.f / 256.f) + EPS);
            FOR_BJ { const f32x4 a = acc[ai][bj][m][0] * r0, b = acc[ai][bj][m][1] * r0; const float ss = red4(dot4(a) + dot4(b));
                *(u32x4*)(QR + (size_t)row * 768 + 256 * pn + 64 * wc + 32 * bj + c8) = pack8(a, b);
                if (fq == 0) QSS[(size_t)row * 24 + 8 * pn + 2 * wc + bj] = ss; } }
    }
};

struct EpiKV {
    static constexpr bool PERM = true, AFTER_DRAIN = false;
    const float* SSKV; const float* KPESS; const float* RPE; const float* gkm; bf16_t* KM; bf16_t* VTM;
    __device__ __forceinline__ void operator()(const f32x4 (&acc)[2][2][4][2], const Unit& u, int wr, int wc, int fr_, int fq_) const {
        int fr = fr_, fq = fq_; asm volatile("" : "+v"(fr), "+v"(fq));
        const int chunk = 4 * u.pn + wc, h = chunk >> 1, rowb = u.pm * 256 + wr * 64 + fr, c8 = 8 * fq; const bool isv = chunk & 1;
        f32x4 gv[2][2];
        FOR_BJ { gv[bj][0] = *(const f32x4*)(gkm + 32 * bj + c8); gv[bj][1] = *(const f32x4*)(gkm + 32 * bj + c8 + 4); }
        f32x2 s2a[2][4]; float kpa[2][4];
        FOR_AI_M { s2a[ai][m] = *(const f32x2*)(SSKV + (size_t)(rowb + ai * 128 + m * 16) * 2); kpa[ai][m] = KPESS[rowb + ai * 128 + m * 16]; }
        FOR_AI_M { ROWFENCE; int row = rowb + ai * 128 + m * 16; asm volatile("" : "+v"(row)); const f32x2 s2 = s2a[ai][m];
            const float r0 = rsqf((s2[0] + s2[1]) * (1.f / 128.f) + EPS); const int b = row >> 12, s = row & 4095;
            if (!isv) {
                f32x4 v[2][2]; float ss = 0.f;
                FOR_BJ { v[bj][0] = acc[ai][bj][m][0] * r0; v[bj][1] = acc[ai][bj][m][1] * r0; ss += dot4(v[bj][0]) + dot4(v[bj][1]); }
                ss = red4(ss) + kpa[ai][m]; const float rstd = rsqf(ss * (1.f / 96.f) + EPS);
                unsigned char* dst = (unsigned char*)KM + ((size_t)(b * 8 + h) * 4096 + s) * 128;
                FOR_BJ *(u32x2*)(dst + 32 * bj + c8) = pack8_fp8(v[bj][0] * rstd * gv[bj][0], v[bj][1] * rstd * gv[bj][1]);
                const f32x4 ra = *(const f32x4*)(RPE + (size_t)row * 32 + c8), rb = *(const f32x4*)(RPE + (size_t)row * 32 + c8 + 4);
                *(u32x2*)(dst + 64 + c8) = pack8_fp8(ra * rstd, rb * rstd);
                *(u32x2*)(dst + 96 + c8) = (u32x2){0u, 0u};
            } else {
                bf16_t* dst = VTM + ((size_t)(b * 8 + h) * 4096 + s) * 64 + c8;
                FOR_BJ *(u32x4*)(dst + 32 * bj) = pack8(acc[ai][bj][m][0] * r0, acc[ai][bj][m][1] * r0);
            } }
    }
};

template <int SECOND> struct EpiY {
    static constexpr bool PERM = true, AFTER_DRAIN = false;
    const bf16_t* SG; bf16_t* Y;
    __device__ __forceinline__ void operator()(const f32x4 (&acc)[2][2][4][2], const Unit& u, int wr, int wc, int fr_, int fq_) const {
        int fr = fr_, fq = fq_; asm volatile("" : "+v"(fr), "+v"(fq));
        const int rowb = u.pm * 256 + wr * 64 + fr, c8 = 8 * fq, colb = 256 * u.pn + 64 * wc + c8;
        u32x2 ga_[2][4][2];
        FOR_AI_M FOR_BJ ga_[ai][m][bj] = *(const u32x2*)((const unsigned char*)SG + (size_t)(rowb + ai * 128 + m * 16) * 1024 + colb + 32 * bj);
#pragma unroll
        for (int ai = 0; ai < 2; ++ai)
#pragma unroll
        for (int mh = 0; mh < 2; ++mh) {
        u32x4 yo_[4][2];
        if (SECOND) {
#pragma unroll
            for (int m = 2 * mh; m < 2 * mh + 2; ++m) FOR_BJ yo_[m][bj] = *(const u32x4*)(Y + (size_t)(rowb + ai * 128 + m * 16) * 1024 + colb + 32 * bj); }
#pragma unroll
        for (int m = 2 * mh; m < 2 * mh + 2; ++m) { ROWFENCE; int row = rowb + ai * 128 + m * 16; asm volatile("" : "+v"(row));
            FOR_BJ { const size_t off = (size_t)row * 1024 + colb + 32 * bj; const u32x2 g = ga_[ai][m][bj];
                const f32x4 ga = (f32x4){(float)(g.x & 0xffu), (float)((g.x >> 8) & 0xffu), (float)((g.x >> 16) & 0xffu), (float)(g.x >> 24)} * (1.f / 255.f);
                const f32x4 gb = (f32x4){(float)(g.y & 0xffu), (float)((g.y >> 8) & 0xffu), (float)((g.y >> 16) & 0xffu), (float)(g.y >> 24)} * (1.f / 255.f);
                f32x4 a = acc[ai][bj][m][0] * ga, b = acc[ai][bj][m][1] * gb;
                if (SECOND) { const u32x4 y = yo_[m][bj]; a += unpk4(y.x, y.y); b += unpk4(y.z, y.w); }
                *(u32x4*)(Y + off) = pack8(a, b); } } }
    }
};

struct PairOrder {
    pg8::StaticOrder base;
    __device__ __forceinline__ bool next(int i, Unit& u) const { if (!base.next(i >> 1, u)) return false; if (i & 1) { u.pm += 256; u.pn += 16; } return true; }
    __device__ __forceinline__ void a_ready(const Unit&) const {}
    __device__ __forceinline__ void done(const Unit&) const {}
};
struct EpiYP {
    static constexpr bool PERM = true, AFTER_DRAIN = false;
    const bf16_t* SGA_; const bf16_t* SGM_; bf16_t* Y;
    __device__ __forceinline__ void operator()(const f32x4 (&acc)[2][2][4][2], const Unit& u, int wr, int wc, int fr_, int fq_) const {
        int fr = fr_, fq = fq_; asm volatile("" : "+v"(fr), "+v"(fq));
        const bool second = u.pm >= 256; const int pm = second ? u.pm - 256 : u.pm, pn = second ? u.pn - 16 : u.pn; const bf16_t* SG = second ? SGM_ : SGA_;
        const int rowb = pm * 256 + wr * 64 + fr, c8 = 8 * fq, colb = 256 * pn + 64 * wc + c8;
        u32x2 ga_[2][4][2];
        FOR_AI_M FOR_BJ ga_[ai][m][bj] = *(const u32x2*)((const unsigned char*)SG + (size_t)(rowb + ai * 128 + m * 16) * 1024 + colb + 32 * bj);
#pragma unroll
        for (int ai = 0; ai < 2; ++ai)
#pragma unroll
        for (int mh = 0; mh < 2; ++mh) {
        u32x4 yo_[4][2];
#pragma unroll
        for (int m = 2 * mh; m < 2 * mh + 2; ++m) FOR_BJ yo_[m][bj] = second ? *(const u32x4*)(Y + (size_t)(rowb + ai * 128 + m * 16) * 1024 + colb + 32 * bj) : (u32x4){0u, 0u, 0u, 0u};
#pragma unroll
        for (int m = 2 * mh; m < 2 * mh + 2; ++m) { ROWFENCE; int row = rowb + ai * 128 + m * 16; asm volatile("" : "+v"(row));
            FOR_BJ { const size_t off = (size_t)row * 1024 + colb + 32 * bj; const u32x2 g = ga_[ai][m][bj];
                const f32x4 ga = (f32x4){(float)(g.x & 0xffu), (float)((g.x >> 8) & 0xffu), (float)((g.x >> 16) & 0xffu), (float)(g.x >> 24)} * (1.f / 255.f);
                const f32x4 gb = (f32x4){(float)(g.y & 0xffu), (float)((g.y >> 8) & 0xffu), (float)((g.y >> 16) & 0xffu), (float)(g.y >> 24)} * (1.f / 255.f);
                const u32x4 y = yo_[m][bj];
                const f32x4 a = acc[ai][bj][m][0] * ga + unpk4(y.x, y.y), b = acc[ai][bj][m][1] * gb + unpk4(y.z, y.w);
                *(u32x4*)(Y + off) = pack8(a, b); } } }
    }
};
struct UqKvOrder {
    pg8::StaticOrder uq, kv; int nuq, kvtile;
    __device__ __forceinline__ bool next(int i, Unit& u) const {
        if (i < nuq) return uq.next(i, u);
        if (!kv.next(i - nuq, u)) return false; u.pm += 256; u.pn += kvtile; return true; }
    __device__ __forceinline__ void a_ready(const Unit&) const {}
    __device__ __forceinline__ void done(const Unit&) const {}
};
struct EpiUqKv {
    static constexpr bool PERM = true, AFTER_DRAIN = false;
    EpiUQ q; EpiKV k; int kvtile;
    __device__ __forceinline__ void operator()(const f32x4 (&acc)[2][2][4][2], const Unit& u, int wr, int wc, int fr, int fq) const {
        if (u.pm >= 256) { Unit v; v.pm = u.pm - 256; v.pn = u.pn - kvtile; k(acc, v, wr, wc, fr, fq); } else q(acc, u, wr, wc, fr, fq);
    }
};
struct EpiOut {
    static constexpr bool PERM = true, AFTER_DRAIN = false;
    const float* xin; float* xout; bf16_t* XB; float* RSX; int last;
    __device__ __forceinline__ void operator()(const f32x4 (&acc)[2][2][4][2], const Unit& u, int wr, int wc, int fr_, int fq_) const {
        int fr = fr_, fq = fq_; asm volatile("" : "+v"(fr), "+v"(fq));
        const int rowb = u.pm * 256 + wr * 64 + fr, c8 = 8 * fq, colb = 256 * u.pn + 64 * wc + c8;
#pragma unroll
        for (int ai = 0; ai < 2; ++ai)
#pragma unroll
        for (int mh = 0; mh < 2; ++mh) {
        f32x4 xa_[4][2][2];
#pragma unroll
        for (int m = 2 * mh; m < 2 * mh + 2; ++m) FOR_BJ { const float* xp = xin + (size_t)(rowb + ai * 128 + m * 16) * 1024 + colb + 32 * bj; xa_[m][bj][0] = *(const f32x4*)xp; xa_[m][bj][1] = *(const f32x4*)(xp + 4); }
#pragma unroll
        for (int m = 2 * mh; m < 2 * mh + 2; ++m) { ROWFENCE; int row = rowb + ai * 128 + m * 16; asm volatile("" : "+v"(row)); float ss = 0.f;
            FOR_BJ { const size_t off = (size_t)row * 1024 + colb + 32 * bj;
                const f32x4 a = xa_[m][bj][0] + acc[ai][bj][m][0], b = xa_[m][bj][1] + acc[ai][bj][m][1];
                *(f32x4*)(xout + off) = a; *(f32x4*)(xout + off + 4) = b; if (!last) *(u32x4*)(XB + off) = pack8(a, b); ss += dot4(a) + dot4(b); }
            ss = red4(ss); if (fq == 0 && !last) atomicAdd(RSX + row, ss); } }
    }
};

struct AttnP { const bf16_t* Q; const bf16_t* K; const bf16_t* VT; const bf16_t* G; bf16_t* O; const float* QSS; const float* gq; const float* cosT; const float* sinT; const float* bias; };

#ifndef NA_STATIC_SKIP
#define NA_STATIC_SKIP 3
#endif
template <bool ISNA, int QB>
__device__ __forceinline__ void att_softmax(f32x16& p0, f32x16& p1, float& lsum, LAS const unsigned char* tb, int dval) {
    if (ISNA) {
#pragma unroll
        for (int r = 0; r < 16; ++r) { const int jc0 = (r & 3) + 8 * (r >> 2), jc1 = jc0 + 32;
            if ((NA_STATIC_SKIP & 2) && QB == 1 && r < 12) p0[r] = 0.f;
            else { const float e0 = __builtin_amdgcn_exp2f(p0[r] + *(LAS const float*)(tb + 4 * jc0)); p0[r] = ((unsigned)(jc0 + dval) < 16u) ? e0 : 0.f; }
            if ((NA_STATIC_SKIP & 1) && QB == 0 && r >= 4) p1[r] = 0.f;
            else { const float e1 = __builtin_amdgcn_exp2f(p1[r] + *(LAS const float*)(tb + 4 * jc1)); p1[r] = ((unsigned)(jc1 + dval) < 16u) ? e1 : 0.f; } }
    } else {
#pragma unroll
        for (int r = 0; r < 16; ++r) { p0[r] = __builtin_amdgcn_exp2f(p0[r]); p1[r] = __builtin_amdgcn_exp2f(p1[r]); }
    }
    float sa = 0.f, sb = 0.f;
#pragma unroll
    for (int r = 0; r < 16; ++r) { sa += p0[r]; sb += p1[r]; }
    lsum += sa + sb;
}
template <int DK, bool ISNA>
__device__ __forceinline__ void att_load_q(const AttnP& P, size_t row, int qtok, int h, int hi, bf16x8 (&qf)[DK / 16]) {
    constexpr int ND = DK / 16;
    if (ISNA) {
        const bf16_t* qp = P.Q + row * 512 + h * 64 + hi * 8;
#pragma unroll
        for (int d0 = 0; d0 < ND; ++d0) { const u32x4 raw = *(const u32x4*)(qp + 16 * d0); qf[d0] = __builtin_bit_cast(bf16x8, raw); }
    } else {
        const bf16_t* qp = P.Q + row * 768 + h * 96 + hi * 8; const float* qs = P.QSS + row * 24 + h * 3;
        const float rstd = rsqf((qs[0] + qs[1] + qs[2]) * (1.f / 96.f) + EPS);
        f32x4 fa[ND], fb[ND];
#pragma unroll
        for (int d0 = 0; d0 < ND; ++d0) { const u32x4 raw = *(const u32x4*)(qp + 16 * d0);
            fa[d0] = unpk4(raw.x, raw.y) * rstd * *(const f32x4*)(P.gq + 16 * d0 + 8 * hi); fb[d0] = unpk4(raw.z, raw.w) * rstd * *(const f32x4*)(P.gq + 16 * d0 + 8 * hi + 4); }
        { const int ti = qtok * 16 + 8 * hi;
          const f32x4 ca = *(const f32x4*)(P.cosT + ti), cb = *(const f32x4*)(P.cosT + ti + 4), sa = *(const f32x4*)(P.sinT + ti), sb = *(const f32x4*)(P.sinT + ti + 4);
          const f32x4 x1a = fa[4 % ND], x1b = fb[4 % ND], x2a = fa[5 % ND], x2b = fb[5 % ND];
          fa[4 % ND] = x1a * ca - x2a * sa; fb[4 % ND] = x1b * cb - x2b * sb; fa[5 % ND] = x1a * sa + x2a * ca; fb[5 % ND] = x1b * sb + x2b * cb; }
#pragma unroll
        for (int d0 = 0; d0 < ND; ++d0) { fa[d0] *= QSC_MLA; fb[d0] *= QSC_MLA; qf[d0] = __builtin_bit_cast(bf16x8, pack8(fa[d0], fb[d0])); }
    }
}
typedef int v8i __attribute__((ext_vector_type(8)));
typedef int i32x4 __attribute__((ext_vector_type(4)));
__device__ __forceinline__ void att_load_q8(const AttnP& P, size_t row, int qtok, int h, int hi, v8i (&q8)[2]) {
    const bf16_t* qp = P.Q + row * 768 + h * 96; const float* qs = P.QSS + row * 24 + h * 3;
    const float rstd = rsqf((qs[0] + qs[1] + qs[2]) * (1.f / 96.f) + EPS) * (QSC_MLA * 16.f);
    f32x4 f0[8], f1[8];
#pragma unroll
    for (int c = 0; c < 4; ++c) { const u32x4 raw = *(const u32x4*)(qp + 32 * hi + 8 * c);
        f0[2 * c] = unpk4(raw.x, raw.y) * rstd * *(const f32x4*)(P.gq + 32 * hi + 8 * c); f0[2 * c + 1] = unpk4(raw.z, raw.w) * rstd * *(const f32x4*)(P.gq + 32 * hi + 8 * c + 4); }
#pragma unroll
    for (int c = 0; c < 8; ++c) f1[c] = (f32x4){0.f, 0.f, 0.f, 0.f};
    if (hi == 0) {
#pragma unroll
        for (int c = 0; c < 4; ++c) { const u32x4 raw = *(const u32x4*)(qp + 64 + 8 * c);
            f1[2 * c] = unpk4(raw.x, raw.y) * rstd * *(const f32x4*)(P.gq + 64 + 8 * c); f1[2 * c + 1] = unpk4(raw.z, raw.w) * rstd * *(const f32x4*)(P.gq + 64 + 8 * c + 4); }
#pragma unroll
        for (int i = 0; i < 4; ++i) { const f32x4 cc = *(const f32x4*)(P.cosT + qtok * 16 + 4 * i), ss = *(const f32x4*)(P.sinT + qtok * 16 + 4 * i);
            const f32x4 x1 = f1[i], x2 = f1[4 + i]; f1[i] = x1 * cc - x2 * ss; f1[4 + i] = x1 * ss + x2 * cc; }
    }
#pragma unroll
    for (int v = 0; v < 8; ++v) { q8[0][v] = (int)pk4_fp8(f0[v][0], f0[v][1], f0[v][2], f0[v][3]); q8[1][v] = (int)pk4_fp8(f1[v][0], f1[v][1], f1[v][2], f1[v][3]); }
}
typedef short s16x4 __attribute__((ext_vector_type(4)));
__device__ __forceinline__ s16x4 att_vtr(LAS const unsigned char* p) { return __builtin_bit_cast(s16x4, __builtin_amdgcn_ds_read_tr16_b64_v4i16((LAS s16x4*)p)); }
__device__ __forceinline__ bf16x8 att_pack(const f32x16& p, int b8) {
    u32x4 pw; pw.x = cvt_pk_bf16(p[b8 + 0], p[b8 + 1]); pw.y = cvt_pk_bf16(p[b8 + 2], p[b8 + 3]); pw.z = cvt_pk_bf16(p[b8 + 4], p[b8 + 5]); pw.w = cvt_pk_bf16(p[b8 + 6], p[b8 + 7]);
    return __builtin_bit_cast(bf16x8, pw);
}
__device__ __forceinline__ void att_store_o(const AttnP& P, size_t row, int h, int hi, const f32x16& o0, const f32x16& o1, float lsum) {
    lsum += __shfl_xor(lsum, 32);
    const float inv = 1.f / lsum;
    const bf16_t* gp = P.G + row * 512 + h * 64 + 4 * hi; bf16_t* op = P.O + row * 512 + h * 64 + 4 * hi;
#pragma unroll
    for (int a = 0; a < 4; ++a) {
        { const u32x2 g = *(const u32x2*)(gp + 8 * a); const f32x4 gg = unpk4(g.x, g.y);
          u32x2 o; o.x = cvt_pk_bf16(o0[4 * a] * inv * gg[0], o0[4 * a + 1] * inv * gg[1]); o.y = cvt_pk_bf16(o0[4 * a + 2] * inv * gg[2], o0[4 * a + 3] * inv * gg[3]); *(u32x2*)(op + 8 * a) = o; }
        { const u32x2 g = *(const u32x2*)(gp + 32 + 8 * a); const f32x4 gg = unpk4(g.x, g.y);
          u32x2 o; o.x = cvt_pk_bf16(o1[4 * a] * inv * gg[0], o1[4 * a + 1] * inv * gg[1]); o.y = cvt_pk_bf16(o1[4 * a + 2] * inv * gg[2], o1[4 * a + 3] * inv * gg[3]); *(u32x2*)(op + 32 + 8 * a) = o; }
    }
}

template <int DK, bool ISNA, bool F8>
__device__ __forceinline__ void attn_phase64(LAS unsigned char* lds, const AttnP& P, int G, int bid) {
    constexpr int DKG = F8 ? 64 : DK;
    constexpr int KP = DKG * 2 + 16, VP = 192  , KBYTES = 64 * KP, STG = KBYTES + 64 * VP, ND = DK / 16, KCH = DKG / 8, TBL = 2 * STG;
    int tid = threadIdx.x; asm volatile("" : "+v"(tid));
    const int lane = tid & 63, w = __builtin_amdgcn_readfirstlane(tid >> 6), r32 = lane & 31, hi = lane >> 5;
    const int vcu = (G & 7) == 0 ? (bid & 7) * (G >> 3) + (bid >> 3) : bid;
        const int ka8 = r32 * KP + hi * 32; const int ka = r32 * KP + hi * 16;
    const int va = KBYTES + (4 * hi + ((lane & 15) >> 2)) * VP + (16 * ((lane >> 4) & 1) + 4 * (lane & 3)) * 2;
    LAS float* tbl = (LAS float*)(lds + TBL + 256);
    constexpr int KC = KCH + 1, NKI = KC, NVI = 12, NI = NKI + NVI;
    int soff[3];
#pragma unroll
    for (int i = 0; i < 3; ++i) { const int j = w + 8 * i;
        if (j < NKI) { const int c = 64 * j + lane, r = c / KC, col = min(c % KC, KCH - 1); soff[i] = r * DKG + col * 8; }
        else { const int c = 64 * (j - NKI) + lane, kr = c / 12, col = min(c % 12, 7); soff[i] = kr * 64 + col * 8; } }
#define ATT_DMA(t, so) do { _Pragma("unroll") for (int i_ = 0; i_ < 3; ++i_) { const int j_ = w + 8 * i_; \
        if (j_ < NKI) __builtin_amdgcn_global_load_lds((const unsigned*)(Kb + (size_t)(t) * 64 * DKG + soff[i_]), (LAS unsigned*)(lds + (so) + j_ * 1024), 16, 0, 0); \
        else if (j_ < NI) __builtin_amdgcn_global_load_lds((const unsigned*)(Vb + (size_t)(t) * 64 * 64 + soff[i_]), (LAS unsigned*)(lds + (so) + KBYTES + (j_ - NKI) * 1024), 16, 0, 0); } } while (0)
#define ATT_SYNC() do { asm volatile("s_waitcnt vmcnt(0)" ::: "memory"); __syncthreads(); } while (0)
    if (w >= 4) __builtin_amdgcn_s_setprio(1);
    for (int u = vcu; u < 1024; u += G) {
        const int bh = u >> 3, qb = u & 7, b = bh >> 3, h = bh & 7;
        const int qtok = qb * 512 + w * 64 + r32; const size_t row = (size_t)b * 4096 + qtok;
        int t_lo = 0, t_hi = 64, my_lo = 0, my_hi = 64, rq = 0;
        if (ISNA) { rq = 8 * qb + w; my_lo = min(max(rq - 4, 0), 56); my_hi = my_lo + 8; t_lo = min(max(8 * qb - 4, 0), 56); t_hi = min(max(8 * qb + 3, 0), 56) + 8; }
        const bf16_t* Kb = P.K + (size_t)bh * 4096 * DKG; const bf16_t* Vb = P.VT + (size_t)bh * 64 * 4096;
        __syncthreads();
        if (ISNA) { for (int i = tid; i < 15 * 32; i += 512) { const int dr = i >> 5, dc = i & 31; tbl[i] = dc < 31 ? P.bias[(h * 15 + dr) * 31 + dc] * LOG2E : 0.f; } }
        ATT_DMA(t_lo, 0);
        bf16x8 qfa[ND], qfb[ND]; v8i qa8[2], qb8[2];
        if (F8) { att_load_q8(P, row, qtok, h, hi, qa8); att_load_q8(P, row + 32, qtok + 32, h, hi, qb8); }
        else { att_load_q<DK, ISNA>(P, row, qtok, h, hi, qfa); att_load_q<DK, ISNA>(P, row + 32, qtok + 32, h, hi, qfb); }
        ATT_SYNC();
        f32x16 oa0, oa1, ob0, ob1;
#pragma unroll
        for (int r = 0; r < 16; ++r) { oa0[r] = 0.f; oa1[r] = 0.f; ob0[r] = 0.f; ob1[r] = 0.f; }
        float lsa = 0.f, lsb = 0.f;
        const int cqa = r32, csa = min(max(cqa - 8, 0), 48), cqb = 32 + r32, csb = min(max(cqb - 8, 0), 48);
        const int coffa = (4 * hi - cqa + 15) * 4, coffb = (4 * hi - cqb + 15) * 4, dvala = 4 * hi - csa, dvalb = 4 * hi - csb;
        int cur = 0;
        for (int t = t_lo; t < t_hi; ++t) {
            const bool more = (t + 1 < t_hi);
            if (more) ATT_DMA(t + 1, (cur ^ 1) * STG);
            if (!ISNA || (t >= my_lo && t < my_hi)) {
                LAS const unsigned char* st = lds + cur * STG;
                f32x16 pa0, pa1, pb0, pb1;
                const f32x16 zz = {0.f, 0.f, 0.f, 0.f, 0.f, 0.f, 0.f, 0.f, 0.f, 0.f, 0.f, 0.f, 0.f, 0.f, 0.f, 0.f};
                if (F8) {
#pragma unroll
                    for (int ks = 0; ks < 2; ++ks) {
                        const i32x4 k0l = *(LAS const i32x4*)(st + ka8 + 64 * ks), k0h = *(LAS const i32x4*)(st + ka8 + 64 * ks + 16);
                        const i32x4 k1l = *(LAS const i32x4*)(st + ka8 + 32 * KP + 64 * ks), k1h = *(LAS const i32x4*)(st + ka8 + 32 * KP + 64 * ks + 16);
                        const v8i k0 = {k0l.x, k0l.y, k0l.z, k0l.w, k0h.x, k0h.y, k0h.z, k0h.w}, k1 = {k1l.x, k1l.y, k1l.z, k1l.w, k1h.x, k1h.y, k1h.z, k1h.w};
                        pa0 = __builtin_amdgcn_mfma_scale_f32_32x32x64_f8f6f4(k0, qa8[ks], ks == 0 ? zz : pa0, 0, 0, 0, 0x7D7D7D7D, 0, 0x7D7D7D7D);
                        pa1 = __builtin_amdgcn_mfma_scale_f32_32x32x64_f8f6f4(k1, qa8[ks], ks == 0 ? zz : pa1, 0, 0, 0, 0x7D7D7D7D, 0, 0x7D7D7D7D);
                        pb0 = __builtin_amdgcn_mfma_scale_f32_32x32x64_f8f6f4(k0, qb8[ks], ks == 0 ? zz : pb0, 0, 0, 0, 0x7D7D7D7D, 0, 0x7D7D7D7D);
                        pb1 = __builtin_amdgcn_mfma_scale_f32_32x32x64_f8f6f4(k1, qb8[ks], ks == 0 ? zz : pb1, 0, 0, 0, 0x7D7D7D7D, 0, 0x7D7D7D7D);
                    }
                } else {
                { const bf16x8 k0 = *(LAS const bf16x8*)(st + ka), k1 = *(LAS const bf16x8*)(st + ka + 32 * KP);
                  pa0 = __builtin_amdgcn_mfma_f32_32x32x16_bf16(k0, qfa[0], zz, 0, 0, 0); pa1 = __builtin_amdgcn_mfma_f32_32x32x16_bf16(k1, qfa[0], zz, 0, 0, 0);
                  pb0 = __builtin_amdgcn_mfma_f32_32x32x16_bf16(k0, qfb[0], zz, 0, 0, 0); pb1 = __builtin_amdgcn_mfma_f32_32x32x16_bf16(k1, qfb[0], zz, 0, 0, 0); }
#pragma unroll
                for (int d0 = 1; d0 < ND; ++d0) {
                    const bf16x8 k0 = *(LAS const bf16x8*)(st + ka + d0 * 32), k1 = *(LAS const bf16x8*)(st + ka + 32 * KP + d0 * 32);
                    pa0 = __builtin_amdgcn_mfma_f32_32x32x16_bf16(k0, qfa[d0], pa0, 0, 0, 0); pa1 = __builtin_amdgcn_mfma_f32_32x32x16_bf16(k1, qfa[d0], pa1, 0, 0, 0);
                    pb0 = __builtin_amdgcn_mfma_f32_32x32x16_bf16(k0, qfb[d0], pb0, 0, 0, 0); pb1 = __builtin_amdgcn_mfma_f32_32x32x16_bf16(k1, qfb[d0], pb1, 0, 0, 0);
                }
                }
                LAS const unsigned char* trow = (LAS const unsigned char*)tbl + (t - rq + 7) * 128;
                att_softmax<ISNA, 0>(pa0, pa1, lsa, trow + coffa, dvala);
                att_softmax<ISNA, 1>(pb0, pb1, lsb, trow + coffb, dvalb);
#pragma unroll
                for (int ks = 0; ks < 4; ++ks) {
                    const s16x4 a0l = att_vtr(st + va + ks * 16 * VP), a0h = att_vtr(st + va + ks * 16 * VP + 8 * VP), a1l = att_vtr(st + va + ks * 16 * VP + 64), a1h = att_vtr(st + va + ks * 16 * VP + 8 * VP + 64);
                    const bf16x8 v0 = {a0l[0], a0l[1], a0l[2], a0l[3], a0h[0], a0h[1], a0h[2], a0h[3]}, v1 = {a1l[0], a1l[1], a1l[2], a1l[3], a1h[0], a1h[1], a1h[2], a1h[3]};
                    const bf16x8 xa = att_pack(ks < 2 ? pa0 : pa1, 8 * (ks & 1)), xb = att_pack(ks < 2 ? pb0 : pb1, 8 * (ks & 1));
                    if (!(ISNA && ks == 3)) { oa0 = __builtin_amdgcn_mfma_f32_32x32x16_bf16(v0, xa, oa0, 0, 0, 0); oa1 = __builtin_amdgcn_mfma_f32_32x32x16_bf16(v1, xa, oa1, 0, 0, 0); }
                    if (!(ISNA && ks == 0)) { ob0 = __builtin_amdgcn_mfma_f32_32x32x16_bf16(v0, xb, ob0, 0, 0, 0); ob1 = __builtin_amdgcn_mfma_f32_32x32x16_bf16(v1, xb, ob1, 0, 0, 0); }
                }
            }
            ATT_SYNC();
            cur ^= 1;
        }
        att_store_o(P, row, h, hi, oa0, oa1, lsa); att_store_o(P, row + 32, h, hi, ob0, ob1, lsb);
    }
    __builtin_amdgcn_s_setprio(0);
    __syncthreads();
#undef ATT_DMA
#undef ATT_SYNC
}

template <int MODE  >
__device__ __forceinline__ void prep_item(const float* W, int Ksrc, int Kpad, int Nsrc, const float* gain, bf16_t* dst, int kb, int grp, LAS float* scr, int lane) {
    const int p0 = grp * 32, within = p0 & 255, L0 = (p0 & ~255) + 64 * ((within >> 5) & 3) + 32 * (within >> 7), k0 = kb * 64;
    int src0 = L0; bool valid = true;
    if (MODE == 1) { if (L0 >= 2464) { if (L0 < 2560) valid = false; else src0 = L0 - 96; } }
    if (k0 >= Ksrc) valid = false;
#pragma unroll
    for (int i = 0; i < 8; ++i) { const int kk = 8 * i + (lane >> 3), n4 = (lane & 7) * 4;
        f32x4 v = {0.f, 0.f, 0.f, 0.f};
        if (valid) { v = *(const f32x4*)(W + (size_t)(k0 + kk) * Nsrc + src0 + n4); if (gain) v = v * gain[k0 + kk]; }
        LAS float* d = scr + kk * 33 + n4; d[0] = v[0]; d[1] = v[1]; d[2] = v[2]; d[3] = v[3]; }
    asm volatile("s_waitcnt lgkmcnt(0)" ::: "memory");
    const int c = lane & 7;
#pragma unroll
    for (int j = 0; j < 4; ++j) { const int n = (lane >> 3) + 8 * j; const LAS float* sp = scr + (8 * c) * 33 + n;
        u32x4 o; o.x = cvt_pk_bf16(sp[0], sp[33]); o.y = cvt_pk_bf16(sp[66], sp[99]); o.z = cvt_pk_bf16(sp[132], sp[165]); o.w = cvt_pk_bf16(sp[198], sp[231]);
        *(u32x4*)(dst + (size_t)(p0 + n) * Kpad + k0 + 8 * c) = o; }
    asm volatile("s_waitcnt lgkmcnt(0)" ::: "memory");
}
template <int MODE>
__device__ __forceinline__ void prep_w(const float* W, int Ksrc, int Kpad, int Nsrc, int Npad, const float* gain, bf16_t* dst, LAS float* scr, int lane, int gw, int ngw) {
    const int ngrp = Npad >> 5, total = ngrp * (Kpad >> 6);
    for (int it = gw; it < total; it += ngw) prep_item<MODE>(W, Ksrc, Kpad, Nsrc, gain, dst, it / ngrp, it % ngrp, scr, lane);
}
__device__ __forceinline__ void sincos_d(double a, float& c, float& s) {
    const double q = __builtin_rint(a * 0.63661977236758134308);
    const double r = (a - q * 1.57079632679489655800) - q * 6.12323399573676603587e-17, r2 = r * r;
    double sp = -7.6471637318198164759e-13; sp = sp * r2 + 1.6059043836821614599e-10; sp = sp * r2 - 2.5052108385441718775e-08; sp = sp * r2 + 2.7557319223985890653e-06;
    sp = sp * r2 - 1.9841269841269841270e-04; sp = sp * r2 + 8.3333333333333333333e-03; sp = sp * r2 - 1.6666666666666666667e-01; const double sn = r + r * r2 * sp;
    double cp = 4.7794773323873852974e-14; cp = cp * r2 - 1.1470745597729724714e-11; cp = cp * r2 + 2.0876756987868098979e-09; cp = cp * r2 - 2.7557319223985890653e-07;
    cp = cp * r2 + 2.4801587301587301587e-05; cp = cp * r2 - 1.3888888888888888889e-03; cp = cp * r2 + 4.1666666666666666667e-02; cp = cp * r2 - 0.5; const double cn = 1.0 + r2 * cp;
    const int qi = (int)q & 3;
    const double cc = (qi == 0) ? cn : (qi == 1) ? -sn : (qi == 2) ? -cn : sn;
    const double ss = (qi == 0) ? sn : (qi == 1) ? cn : (qi == 2) ? -sn : -cn;
    c = (float)cc; s = (float)ss;
}

#define XB_TMO      128
#define XB_XCNT(j)  (256  + 64 * (j))
#define XB_XSUB(j)  (1280 + 64 * (j))
#define XB_XGEN(j)  (2304 + 64 * (j))
#define XB_TOP      3328
#define XB_TOPGEN   3392
#define XCD_BAR_WORDS 3456
#define XB_SPIN_CAP (1u << 18)

__device__ __forceinline__ unsigned xb_ld(unsigned* p)              { return __hip_atomic_load(p, __ATOMIC_RELAXED, __HIP_MEMORY_SCOPE_AGENT); }
__device__ __forceinline__ unsigned xb_add(unsigned* p, unsigned v) { return __hip_atomic_fetch_add(p, v, __ATOMIC_RELAXED, __HIP_MEMORY_SCOPE_AGENT); }
__device__ __forceinline__ unsigned xb_xcc_id() { return (unsigned)__builtin_amdgcn_s_getreg((3 << 11) | 20) & 0xFu; }
#define XB_SPIN(cond, bar) do { unsigned _sp = 0; while (cond) { __builtin_amdgcn_s_sleep(1); \
    if ((++_sp & 255u) == 0u) { if (xb_ld(&(bar)[XB_TMO])) break; if (_sp > XB_SPIN_CAP) { atomicAdd(&(bar)[XB_TMO], 1u); break; } } } } while (0)

struct XcdBarrier {
    unsigned* bar; unsigned x;
    volatile LAS unsigned* st;
};

__device__ __forceinline__ XcdBarrier xcd_barrier_post(unsigned* bar, volatile LAS unsigned* st) {
    XcdBarrier b; b.bar = bar; b.x = xb_xcc_id(); b.st = st;
    if (threadIdx.x == 0) (void)xb_add(&bar[XB_XCNT(b.x)], 1u);
    return b;
}
__device__ __forceinline__ void xcd_barrier_complete(unsigned* bar, unsigned x, unsigned& nloc, unsigned& nx) {
    const unsigned G = gridDim.x * gridDim.y * gridDim.z;
    unsigned sum, cnt, mine, sp = 0u;
    for (;;) {
        sum = 0u; cnt = 0u; mine = 0u;
#pragma unroll
        for (unsigned j = 0; j < 16; ++j) { const unsigned c = xb_ld(&bar[XB_XCNT(j)]); sum += c; cnt += (c > 0u) ? 1u : 0u; mine = (j == x) ? c : mine; }
        if (sum == G) break;
        __builtin_amdgcn_s_sleep(1);
        if ((++sp & 255u) == 0u) { if (xb_ld(&bar[XB_TMO])) break; if (sp > XB_SPIN_CAP) { atomicAdd(&bar[XB_TMO], 1u); break; } }
    }
    nloc = mine > 0u ? mine : 1u; nx = cnt > 0u ? cnt : 1u;
}

__device__ __forceinline__ void xcd_barrier(const XcdBarrier& b) {
    asm volatile("s_waitcnt vmcnt(0)" ::: "memory");
    __syncthreads();
    if (threadIdx.x == 0) {
        unsigned* bar = b.bar;
        __builtin_amdgcn_s_waitcnt(0);
        unsigned nloc = b.st[0], nx = b.st[1];
        if (nloc == 0u) { xcd_barrier_complete(bar, b.x, nloc, nx); b.st[0] = nloc; b.st[1] = nx; }
        const unsigned old = xb_add(&bar[XB_XSUB(b.x)], 1u);
        const unsigned gen = old / nloc;
        if (old + 1u == (gen + 1u) * nloc) {
            __builtin_amdgcn_fence(__ATOMIC_RELEASE, "agent");
            asm volatile("s_waitcnt vmcnt(0)" ::: "memory");
            const unsigned og = xb_add(&bar[XB_TOP], 1u);
            const unsigned tg = og / nx;
            if (og + 1u == (tg + 1u) * nx) xb_add(&bar[XB_TOPGEN], 1u);
            else XB_SPIN(xb_ld(&bar[XB_TOPGEN]) == tg, bar);
            __builtin_amdgcn_fence(__ATOMIC_ACQUIRE, "agent");
            xb_add(&bar[XB_XGEN(b.x)], 1u);
            asm volatile("s_waitcnt vmcnt(0)" ::: "memory");
        } else {
            XB_SPIN(xb_ld(&bar[XB_XGEN(b.x)]) == gen, bar);
            __builtin_amdgcn_fence(__ATOMIC_ACQUIRE, "agent");
            asm volatile("s_waitcnt vmcnt(0)" ::: "memory");
        }
    }
    __syncthreads();
}

struct Params { const float* in[15]; float* out; unsigned char* ws; };

#define WSB() size_t wz_ = 0; asm volatile("" : "+s"(wz_)); unsigned char* wsl = p.ws + wz_
#define WP(T, off) ((T*)(wsl + (off)))
__global__ void __launch_bounds__(512, 2) hybrid_fwd(Params p) {
    extern __shared__ __attribute__((aligned(16))) unsigned char lds_raw[];
    LAS unsigned char* lds = (LAS unsigned char*)lds_raw;
    cg::grid_group grid = cg::this_grid();
    const int tid = threadIdx.x, G = gridDim.x, bid = blockIdx.x;
    const int gtid = bid * 512 + tid, gthreads = G * 512;
    volatile LAS unsigned* xst = (volatile LAS unsigned*)(lds + 131072);
    if (tid < 16) xst[tid] = 0u;
    __syncthreads();
    const XcdBarrier xbar = xcd_barrier_post((unsigned*)(p.ws + WS_BND), xst);

    { WSB();
      const float* ln_g = p.in[1]; const float* w_in = p.in[2]; const float* cq_norm = p.in[6]; const float* ckv_norm = p.in[7]; const float* w_uq = p.in[8]; const float* w_ukv = p.in[9];
      const float* w_o_na = p.in[12]; const float* w_o_mla = p.in[13]; const float* w_out = p.in[14];
      LAS float* scr = (LAS float*)(lds + (tid >> 6) * 8704); const int gwave = bid * 8 + (tid >> 6), nwave = G * 8;
      for (int l = 0; l < NLAYER; ++l) {
        prep_w<1>(w_in + (size_t)l * 1024 * DIN, 1024, 1024, DIN, NIN, ln_g + l * 1024, WP(bf16_t, WS_WIN) + (size_t)l * NIN * 1024, scr, tid & 63, gwave, nwave);
        prep_w<0>(w_uq + (size_t)l * 256 * 768, 256, 256, 768, 768, cq_norm + l * 256, WP(bf16_t, WS_WUQ) + (size_t)l * 768 * 256, scr, tid & 63, gwave, nwave);
        prep_w<0>(w_ukv + (size_t)l * 128 * 1024, 128, 256, 1024, 1024, ckv_norm + l * 128, WP(bf16_t, WS_WUKV) + (size_t)l * 1024 * 256, scr, tid & 63, gwave, nwave);
        prep_w<0>(w_o_na + (size_t)l * 512 * 1024, 512, 512, 1024, 1024, nullptr, WP(bf16_t, WS_WONA) + (size_t)l * 1024 * 512, scr, tid & 63, gwave, nwave);
        prep_w<0>(w_o_mla + (size_t)l * 512 * 1024, 512, 512, 1024, 1024, nullptr, WP(bf16_t, WS_WOMLA) + (size_t)l * 1024 * 512, scr, tid & 63, gwave, nwave);
        prep_w<0>(w_out + (size_t)l * 1024 * 1024, 1024, 1024, 1024, 1024, nullptr, WP(bf16_t, WS_WOUT) + (size_t)l * 1024 * 1024, scr, tid & 63, gwave, nwave);
      }
      float* COS = WP(float, WS_COS); float* SIN = WP(float, WS_SIN);
      for (int idx = gtid; idx < SEQ * 16; idx += gthreads) {
        const int pos = idx >> 4, i = idx & 15, k = i & 7; const int coord = (i < 8) ? (pos >> 6) : (pos & 63);
        double inv = (k & 1) ? 0.31622776601683794 : 1.0; const int e = k >> 1; inv *= (e == 0) ? 1.0 : (e == 1) ? 0.1 : (e == 2) ? 0.01 : 0.001;
        float c, s; sincos_d((double)coord * inv, c, s); COS[idx] = c; SIN[idx] = s;
      }
      { const int lane = tid & 63, wave = tid >> 6; const int gw = bid * 8 + wave, NGW = G * 8;
        const float* x_in = p.in[0]; bf16_t* XB = WP(bf16_t, WS_XB); float* RSX = WP(float, WS_RSX);
        for (int m0 = gw; m0 < MTOK; m0 += 4 * NGW) {
          f32x4 v[4][4];
#pragma unroll
          for (int r = 0; r < 4; ++r) { const f32x4* xr = (const f32x4*)(x_in + (size_t)min(m0 + r * NGW, MTOK - 1) * 1024) + lane;
#pragma unroll
            for (int j = 0; j < 4; ++j) v[r][j] = xr[64 * j]; }
#pragma unroll
          for (int r = 0; r < 4; ++r) { const int m = m0 + r * NGW; float ss = 0.f; if (m >= MTOK) break;
#pragma unroll
            for (int j = 0; j < 4; ++j) { ss += dot4(v[r][j]); u32x2 o; o.x = cvt_pk_bf16(v[r][j][0], v[r][j][1]); o.y = cvt_pk_bf16(v[r][j][2], v[r][j][3]);
                *(u32x2*)(XB + (size_t)m * 1024 + (64 * j + lane) * 4) = o; }
#pragma unroll
            for (int o = 1; o < 64; o <<= 1) ss += __shfl_xor(ss, o);
            if (lane == 0) RSX[m] = ss; } } }
    }
    grid.sync();

    for (int l = 0; l < NLAYER; ++l) {
        { WSB(); pg8::Gemm g{WP(bf16_t, WS_XB), WP(bf16_t, WS_WIN) + (size_t)l * NIN * 1024, MTOK, NIN, opq(1024)}; pg8::StaticOrder S; S.init(MTOK, NIN, G, bid);
          EpiInProj E{WP(float, WS_RSX), p.in[3] + l * 64, p.in[4] + l * 64, p.in[11] + l * 96, WP(float, WS_COS), WP(float, WS_SIN), WP(bf16_t, WS_QNA), WP(bf16_t, WS_KNA), WP(bf16_t, WS_VTNA), WP(bf16_t, WS_GA),
                      WP(bf16_t, WS_CQ), WP(bf16_t, WS_CKV), WP(bf16_t, WS_GM), WP(bf16_t, WS_SGA), WP(bf16_t, WS_SGM), WP(float, WS_SSQ), WP(float, WS_SSKV), WP(float, WS_KPESS), WP(float, WS_RPE)};
          pg8::gemm_phase<EpiInProj, pg8::StaticOrder, true, true>(lds, g, S, E);
          }
        xcd_barrier(xbar);
        { WSB(); float* RSX = WP(float, WS_RSX); for (int i = gtid; i < MTOK; i += gthreads) RSX[i] = 0.f; }
        { WSB(); AttnP A{WP(bf16_t, WS_QNA), WP(bf16_t, WS_KNA), WP(bf16_t, WS_VTNA), WP(bf16_t, WS_GA), WP(bf16_t, WS_QNA), nullptr, nullptr, nullptr, nullptr, p.in[5] + (size_t)l * 8 * 465};
          attn_phase64<64, true, false>(lds, A, G, bid); }
        { WSB(); pg8::Gemm g{WP(bf16_t, WS_CQ), WP(bf16_t, WS_WUQ) + (size_t)l * 768 * 256, 2 * MTOK, 8192, opq(256)};
          UqKvOrder S; S.uq.init(MTOK, 768, G, bid); S.kv.init(MTOK, 1024, G, bid); S.nuq = ((MTOK / 256) * 3 + G - 1 - bid) / G; S.kvtile = 16 + l;
          EpiUqKv E{EpiUQ{WP(float, WS_SSQ), WP(bf16_t, WS_XB), WP(float, WS_QSS)}, EpiKV{WP(float, WS_SSKV), WP(float, WS_KPESS), WP(float, WS_RPE), p.in[11] + l * 96, WP(bf16_t, WS_KMLA), WP(bf16_t, WS_VTMLA)}, 16 + l};
          pg8::gemm_phase<EpiUqKv, UqKvOrder, true, true>(lds, g, S, E); }
        xcd_barrier(xbar);
        { WSB(); AttnP A{WP(bf16_t, WS_XB), WP(bf16_t, WS_KMLA), WP(bf16_t, WS_VTMLA), WP(bf16_t, WS_GM), WP(bf16_t, WS_OMLA), WP(float, WS_QSS), p.in[10] + l * 96, WP(float, WS_COS), WP(float, WS_SIN), nullptr};
          attn_phase64<96, false, true>(lds, A, G, bid);
          }
        xcd_barrier(xbar);
        { WSB(); pg8::Gemm g{WP(bf16_t, WS_QNA), WP(bf16_t, WS_WONA) + (size_t)l * 1024 * 512, 2 * MTOK, 4096 + 1024, opq(512)}; PairOrder S; S.base.init(MTOK, 1024, G, bid);
          EpiYP E{WP(bf16_t, WS_SGA), WP(bf16_t, WS_SGM), WP(bf16_t, WS_Y)}; pg8::gemm_phase<EpiYP, PairOrder, true, true>(lds, g, S, E); }
        xcd_barrier(xbar);
        { WSB(); pg8::Gemm g{WP(bf16_t, WS_Y), WP(bf16_t, WS_WOUT) + (size_t)l * 1024 * 1024, MTOK, 1024, opq(1024)}; pg8::StaticOrder S; S.init(MTOK, 1024, G, bid);
          EpiOut E{l == 0 ? p.in[0] : p.out, p.out, WP(bf16_t, WS_XB), WP(float, WS_RSX), l == NLAYER - 1 ? 1 : 0}; pg8::gemm_phase<EpiOut, pg8::StaticOrder, true, true>(lds, g, S, E); }
        if (l + 1 < NLAYER) xcd_barrier(xbar);
    }
}

extern "C" void kernel_launch(void* const* d_in, const int* in_sizes, int n_in, void* d_out, int out_size, void* d_ws, size_t ws_size, hipStream_t stream) {
    static int grid = 0;
    if (grid == 0) {
        if (n_in != 15 || in_sizes[0] != MTOK * 1024 || out_size != MTOK * 1024 || ws_size < WS_END) {
            fprintf(stderr, "kernel_launch: unexpected shapes (n_in %d, in0 %d, out %d, ws %zu, need %zu); nothing launched\n", n_in, n_in > 0 ? in_sizes[0] : -1, out_size, ws_size, (size_t)WS_END); grid = -1; return; }
        int dev = 0, cus = 0, per_cu = 0;
        (void)hipGetDevice(&dev); (void)hipDeviceGetAttribute(&cus, hipDeviceAttributeMultiprocessorCount, dev);
        if (hipFuncSetAttribute((const void*)hybrid_fwd, hipFuncAttributeMaxDynamicSharedMemorySize, LDS_BYTES) != hipSuccess) fprintf(stderr, "kernel_launch: hipFuncSetAttribute failed\n");
        if (hipOccupancyMaxActiveBlocksPerMultiprocessor(&per_cu, (const void*)hybrid_fwd, 512, LDS_BYTES) != hipSuccess || per_cu < 1) { fprintf(stderr, "kernel_launch: occupancy query gave %d; using 1\n", per_cu); per_cu = 1; }
        (void)hipGetLastError();
        if (cus <= 0) cus = 256;
        if (per_cu > 1) per_cu = 1;
        grid = cus * per_cu;
    }
    if (grid < 0) return;
    if (hipMemsetAsync((char*)d_ws + WS_BND, 0, XCD_BAR_WORDS * 4, stream) != hipSuccess) { fprintf(stderr, "kernel_launch: memset of barrier words failed\n"); return; }
    Params p{};
    for (int i = 0; i < 15; ++i) p.in[i] = (const float*)d_in[i];
    p.out = (float*)d_out; p.ws = (unsigned char*)d_ws;
    void* args[] = {&p};
    hipError_t e = hipLaunchCooperativeKernel((const void*)hybrid_fwd, dim3(grid), dim3(512), args, LDS_BYTES, stream);
    if (e != hipSuccess) fprintf(stderr, "kernel_launch: cooperative launch failed: %s (grid %d)\n", hipGetErrorString(e), grid);
}
```
